# Optimizing an MI355X kernel written in HIP

```python
import math, functools
import jax, jax.numpy as jnp
from jax import lax
import numpy as np

D_MODEL = 2048
BATCH = 32
SEQ = 256
DEPTH = 2
DEC_BATCH = 2
DEC_SEQ = 2048
PAST_LEN = 512

GRID_W = 64
N_HEADS = D_MODEL // 128
HEAD_DIM = 64
ATTN_W = N_HEADS * HEAD_DIM
SSM_W = D_MODEL // 4
SSM_GROUP = 16
SSM_GROUPS = SSM_W // SSM_GROUP
SSM_STATE = 64
POOL_W = D_MODEL // 4
POOL_WINDOWS = (2, 4, 8, 16)
POOL_GROUP = POOL_W // len(POOL_WINDOWS)
IN_W = 3 * ATTN_W + SSM_W + POOL_W
SPLITS = (ATTN_W, 2 * ATTN_W, 3 * ATTN_W, 3 * ATTN_W + SSM_W)
WIN_ROWS_MAX = 8
WIN_COLS = 16
Q_BLOCK = 128
FFN_HIDDEN = ((8 * D_MODEL + 3 * 256 - 1) // (3 * 256)) * 256
RMS_EPS = 1e-6
NEG_INF = -1e30

kernel_name = 'hybrid_s5_natten_pool_diffusion_step'


def rms_norm(x, g):
    xf = x.astype(jnp.float32)
    y = xf * lax.rsqrt(jnp.mean(xf * xf, axis=-1, keepdims=True) + RMS_EPS)
    return (y * g.astype(jnp.float32)).astype(x.dtype)


def modulation(cond, w_mod, b_mod):
    m = jax.nn.silu(cond) @ w_mod + b_mod
    return [t[:, None, :] for t in jnp.split(m, 6, axis=-1)]


def to_heads(t):
    b, n, _ = t.shape
    return t.reshape(b, n, N_HEADS, HEAD_DIM).transpose(0, 2, 1, 3)


def from_heads(t):
    b, h, n, d = t.shape
    return t.transpose(0, 2, 1, 3).reshape(b, n, h * d)


def context_attention(q, k, v):
    b, h, n, d = q.shape
    qb = q.reshape(b, h, n // Q_BLOCK, Q_BLOCK, d).transpose(2, 0, 1, 3, 4)

    def block(qi):
        s = jnp.einsum('bhqd,bhkd->bhqk', qi, k).astype(jnp.float32) * HEAD_DIM ** -0.5
        p = jax.nn.softmax(s, axis=-1).astype(v.dtype)
        return jnp.einsum('bhqk,bhkd->bhqd', p, v)

    o = lax.map(block, qb)
    return o.transpose(1, 2, 0, 3, 4).reshape(b, h, n, d)


def latent_attention(q, k, v, ctx_k, ctx_v, rpb):
    f32 = jnp.float32
    b, h, n, d = q.shape
    rows = n // GRID_W
    wr = min(WIN_ROWS_MAX, rows)
    scale = HEAD_DIM ** -0.5
    qg = q.reshape(b, h, rows, GRID_W, d).transpose(2, 0, 1, 3, 4)
    kg = k.reshape(b, h, rows, GRID_W, d)
    vg = v.reshape(b, h, rows, GRID_W, d)
    cols = jnp.arange(GRID_W)
    col_start = jnp.clip(cols - WIN_COLS // 2, 0, GRID_W - WIN_COLS)
    col_mask = (cols[None, :] >= col_start[:, None]) & (cols[None, :] < col_start[:, None] + WIN_COLS)
    dc_idx = jnp.clip(cols[None, :] - cols[:, None], 1 - WIN_COLS, WIN_COLS - 1) + WIN_COLS - 1

    def row(args):
        r, qr = args
        rs = jnp.clip(r - wr // 2, 0, rows - wr)
        kb = lax.dynamic_slice_in_dim(kg, rs, wr, axis=2)
        vb = lax.dynamic_slice_in_dim(vg, rs, wr, axis=2)
        dr_idx = rs + jnp.arange(wr) - r + WIN_ROWS_MAX - 1
        bias = rpb[:, dr_idx[None, :, None], dc_idx[:, None, :]].astype(f32)
        s_loc = jnp.einsum('bhqd,bhrkd->bhqrk', qr, kb).astype(f32) * scale + bias
        s_loc = jnp.where(col_mask[:, None, :], s_loc, NEG_INF).reshape(b, h, GRID_W, wr * GRID_W)
        s_ctx = jnp.einsum('bhqd,bhld->bhql', qr, ctx_k).astype(f32) * scale
        p = jax.nn.softmax(jnp.concatenate([s_loc, s_ctx], axis=-1), axis=-1).astype(v.dtype)
        p_loc = p[..., :wr * GRID_W].reshape(b, h, GRID_W, wr, GRID_W)
        return (jnp.einsum('bhqrk,bhrkd->bhqd', p_loc, vb)
                + jnp.einsum('bhql,bhld->bhqd', p[..., wr * GRID_W:], ctx_v))

    o = lax.map(row, (jnp.arange(rows), qg))
    return o.transpose(1, 2, 0, 3, 4).reshape(b, h, n, d)


def _scan_combine(e1, e2):
    a1, b1 = e1
    a2, b2 = e2
    return a1 * a2, a2 * b1 + b2


def diag_scan(a_bar, bu, h0, reverse):
    a = jnp.broadcast_to(a_bar, bu.shape)
    a_cum, h = lax.associative_scan(_scan_combine, (a, bu), reverse=reverse, axis=1)
    return h + a_cum * h0[:, None]


def ssm_mixer(u, h0, a_re, a_im, log_dt, b_re, b_im, c_re, c_im, d_skip, w_glu, b_glu):
    f32 = jnp.float32
    bsz, n, _ = u.shape
    lam = lax.complex(a_re.astype(f32), a_im.astype(f32))
    dt = jnp.exp(log_dt.astype(f32))[..., None]
    a_bar = jnp.exp(lam * dt)
    b_bar = ((a_bar - 1.0) / lam)[..., None] * lax.complex(b_re.astype(f32), b_im.astype(f32))
    c_mat = lax.complex(c_re.astype(f32), c_im.astype(f32))
    uf = u.astype(f32)
    ug = uf.reshape(bsz, n, SSM_GROUPS, SSM_GROUP)
    y = d_skip.astype(f32) * uf
    finals = []
    for direction, rev in ((0, False), (1, True)):
        bu = jnp.einsum('btgm,gpm->btgp', ug, b_bar[direction])
        h = diag_scan(a_bar[direction], bu, h0[:, direction], rev)
        y = y + jnp.real(jnp.einsum('btgp,gmp->btgm', h, c_mat[direction])).reshape(bsz, n, SSM_W)
        finals.append(h[:, 0] if rev else h[:, -1])
    z = jax.nn.gelu(y).astype(u.dtype) @ w_glu + b_glu
    z_val, z_gate = jnp.split(z, 2, axis=-1)
    return z_val * jax.nn.sigmoid(z_gate), jnp.stack(finals, axis=1)


def pool_mixer(p, w_pool, pool_scale):
    f32 = jnp.float32
    bsz, n, _ = p.shape
    ng = len(POOL_WINDOWS)
    pf = p.astype(f32).reshape(bsz, n, ng, POOL_GROUP)
    csum = jnp.concatenate([jnp.zeros((bsz, 1, ng, POOL_GROUP), f32), jnp.cumsum(pf, axis=1)], axis=1)
    t = jnp.arange(n)[:, None]
    win = jnp.array(POOL_WINDOWS, dtype=jnp.int32)[None, :]
    lo = jnp.clip(t - win // 2, 0, n)
    hi = jnp.clip(t - win // 2 + win, 0, n)
    g_idx = jnp.arange(ng)[None, :]
    sums = csum[:, hi, g_idx] - csum[:, lo, g_idx]
    mixed = sums / (hi - lo).astype(f32)[None, :, :, None] - pf
    out = jnp.einsum('btgc,gcd->btgd', mixed, w_pool.astype(f32)).reshape(bsz, n, POOL_W)
    return (out * pool_scale.astype(f32)).astype(p.dtype)


def swiglu(h, w_in, w_out):
    g, u = jnp.split(h @ w_in, 2, axis=-1)
    return (jax.nn.silu(g) * u) @ w_out


def trunk_layer(x, cond, lp, attend, h0):
    sh1, sc1, g1, sh2, sc2, g2 = modulation(cond, lp['w_mod'], lp['b_mod'])
    h = rms_norm(x, lp['norm1_g']) * (1 + sc1) + sh1
    q, k, v, u, p = jnp.split(h @ lp['w_in'], SPLITS, axis=-1)
    q, k, v = to_heads(q), to_heads(k), to_heads(v)
    a_out = from_heads(attend(q, k, v))
    s_out, s_final = ssm_mixer(u, h0, lp['ssm_a_re'], lp['ssm_a_im'], lp['ssm_log_dt'],
                               lp['ssm_b_re'], lp['ssm_b_im'], lp['ssm_c_re'], lp['ssm_c_im'],
                               lp['ssm_d'], lp['ssm_w_glu'], lp['ssm_b_glu'])
    p_out = pool_mixer(p, lp['pool_w'], lp['pool_scale'])
    mixed = jnp.concatenate([a_out, s_out, p_out], axis=-1) @ lp['w_out']
    x = x + g1 * mixed
    h2 = rms_norm(x, lp['norm2_g']) * (1 + sc2) + sh2
    x = x + g2 * swiglu(h2, lp['ffn_w_in'], lp['ffn_w_out'])
    return x, k, v, s_final


def setup_inputs(seed: int = 0) -> dict:
    key = jax.random.key(seed)
    ks = jax.random.split(key, 32)
    f32 = jnp.float32
    L, D, G, P, M = DEPTH, D_MODEL, SSM_GROUPS, SSM_STATE, SSM_GROUP

    def nrm(k, shape, scale):
        return jax.random.normal(k, shape, f32) * scale

    n_idx = jnp.arange(P, dtype=f32)
    return {
        'x_prompt': nrm(ks[0], (BATCH, SEQ, D), 1.0),
        'x_sample': nrm(ks[1], (DEC_BATCH, DEC_SEQ, D), 1.0),
        'c': nrm(ks[2], (DEC_BATCH, D), 1.0),
        'cache_k': nrm(ks[3], (DEC_BATCH, L, N_HEADS, PAST_LEN, HEAD_DIM), 1.0),
        'cache_v': nrm(ks[4], (DEC_BATCH, L, N_HEADS, PAST_LEN, HEAD_DIM), 1.0),
        'state_ssm': nrm(ks[5], (DEC_BATCH, L, 2, G, P, 2), 0.5),
        'c_ctx': nrm(ks[6], (D,), 1.0),
        'w_mod': nrm(ks[7], (L, D, 6 * D), 0.5 * D ** -0.5),
        'b_mod': nrm(ks[8], (L, 6 * D), 0.01),
        'norm1_g': 1.0 + nrm(ks[9], (L, D), 0.1),
        'norm2_g': 1.0 + nrm(ks[10], (L, D), 0.1),
        'w_in': nrm(ks[11], (L, D, IN_W), D ** -0.5),
        'attn_rpb': nrm(ks[12], (L, N_HEADS, 2 * WIN_ROWS_MAX - 1, 2 * WIN_COLS - 1), 0.1),
        'ssm_a_re': -0.5 + nrm(ks[13], (L, 2, G, P), 0.01),
        'ssm_a_im': math.pi * n_idx + nrm(ks[14], (L, 2, G, P), 0.01),
        'ssm_log_dt': jax.random.uniform(ks[15], (L, 2, G), f32, math.log(1e-3), math.log(1e-1)),
        'ssm_b_re': nrm(ks[16], (L, 2, G, P, M), (2 * M) ** -0.5),
        'ssm_b_im': nrm(ks[17], (L, 2, G, P, M), (2 * M) ** -0.5),
        'ssm_c_re': nrm(ks[18], (L, 2, G, M, P), (2 * P) ** -0.5),
        'ssm_c_im': nrm(ks[19], (L, 2, G, M, P), (2 * P) ** -0.5),
        'ssm_d': nrm(ks[20], (L, SSM_W), 1.0),
        'ssm_w_glu': nrm(ks[21], (L, SSM_W, 2 * SSM_W), SSM_W ** -0.5),
        'ssm_b_glu': nrm(ks[22], (L, 2 * SSM_W), 0.01),
        'pool_w': nrm(ks[23], (L, len(POOL_WINDOWS), POOL_GROUP, POOL_GROUP), POOL_GROUP ** -0.5),
        'pool_scale': 1.0 + nrm(ks[24], (L, POOL_W), 0.1),
        'w_out': nrm(ks[25], (L, D, D), D ** -0.5),
        'ffn_w_in': nrm(ks[26], (L, D, 2 * FFN_HIDDEN), D ** -0.5),
        'ffn_w_out': nrm(ks[27], (L, FFN_HIDDEN, D), FFN_HIDDEN ** -0.5),
        'final_norm_g': 1.0 + nrm(ks[28], (D,), 0.1),
    }


def reference(x_prompt, x_sample, c, cache_k, cache_v, state_ssm, c_ctx, w_mod, b_mod,
              norm1_g, norm2_g, w_in, attn_rpb, ssm_a_re, ssm_a_im, ssm_log_dt,
              ssm_b_re, ssm_b_im, ssm_c_re, ssm_c_im, ssm_d, ssm_w_glu, ssm_b_glu,
              pool_w, pool_scale, w_out, ffn_w_in, ffn_w_out, final_norm_g):
    f32 = jnp.float32

    def layer_params(l):
        return {
            'w_mod': w_mod[l], 'b_mod': b_mod[l], 'norm1_g': norm1_g[l], 'norm2_g': norm2_g[l],
            'w_in': w_in[l], 'ssm_a_re': ssm_a_re[l], 'ssm_a_im': ssm_a_im[l],
            'ssm_log_dt': ssm_log_dt[l], 'ssm_b_re': ssm_b_re[l], 'ssm_b_im': ssm_b_im[l],
            'ssm_c_re': ssm_c_re[l], 'ssm_c_im': ssm_c_im[l], 'ssm_d': ssm_d[l],
            'ssm_w_glu': ssm_w_glu[l], 'ssm_b_glu': ssm_b_glu[l], 'pool_w': pool_w[l],
            'pool_scale': pool_scale[l], 'w_out': w_out[l], 'ffn_w_in': ffn_w_in[l],
            'ffn_w_out': ffn_w_out[l],
        }

    xp = x_prompt
    cond_ctx = c_ctx[None, :]
    h0_ctx = jnp.zeros((x_prompt.shape[0], 2, SSM_GROUPS, SSM_STATE), jnp.complex64)
    ks_out, vs_out, st_out = [], [], []
    for l in range(DEPTH):
        xp, k_l, v_l, fin = trunk_layer(xp, cond_ctx, layer_params(l), context_attention, h0_ctx)
        ks_out.append(k_l)
        vs_out.append(v_l)
        st_out.append(jnp.stack([jnp.real(fin), jnp.imag(fin)], axis=-1))
    y_prompt = rms_norm(xp, final_norm_g)
    new_cache_k = jnp.stack(ks_out, axis=1)
    new_cache_v = jnp.stack(vs_out, axis=1)
    new_state_ssm = jnp.stack(st_out, axis=1)

    xs = x_sample
    for l in range(DEPTH):
        st = state_ssm[:, l]
        h0 = lax.complex(st[..., 0].astype(f32), st[..., 1].astype(f32))
        attend = functools.partial(latent_attention, ctx_k=cache_k[:, l], ctx_v=cache_v[:, l], rpb=attn_rpb[l])
        xs, _, _, _ = trunk_layer(xs, c, layer_params(l), attend, h0)
    y_sample = rms_norm(xs, final_norm_g)

    return (y_prompt, y_sample, new_cache_k, new_cache_v, new_state_ssm)
```

```cpp
#include <hip/hip_runtime.h>
#include <cstdio>
#include <cstdint>

#ifndef PHMASK
#define PHMASK 0xFFFF
#endif
#define PHON(k) (((PHMASK) >> (k)) & 1)
#ifndef MK_N_LAUNCHES
#define MK_N_LAUNCHES 1
#endif

namespace pg8 {
#define PG8_LAS __attribute__((address_space(3)))
typedef unsigned short bf16_t;
typedef short bf16x8 __attribute__((ext_vector_type(8)));
typedef float f32x4 __attribute__((ext_vector_type(4)));
typedef unsigned u32x4 __attribute__((ext_vector_type(4)));
constexpr int BM = 256, BK = 64, HALF = 128, HTB = HALF * BK * 2, STAGE_BYTES = 8 * HTB, NXCD = 8, WGM = 8;

__host__ __device__ __forceinline__ int lds_byte(int r, int c) { const int st = (r >> 4) * 2 + (c >> 5), rr = r & 15, cc = c & 31, ob = rr * 64 + cc * 2; return st * 1024 + (ob ^ (((ob >> 9) & 1) << 5)); }
__host__ __device__ __forceinline__ void stage_rc(int b, int& R, int& C) { const int st = b / 1024, sb = b % 1024, swz = sb ^ (((sb >> 9) & 1) << 5); R = (st >> 1) * 16 + swz / 64; C = (st & 1) * 32 + (swz % 64) / 2; }

struct Unit { int pm, pn; };
struct Gemm { const bf16_t* A; const bf16_t* Bt; int M, N, K; };

struct StaticOrder {
    int nM, nN, nwg, G, c;
    __host__ __device__ void init(int M, int N, int G_, int c_) { nM = M / BM; nN = N / BM; nwg = nM * nN; G = G_; c = c_; }
    __host__ __device__ bool next(int i, Unit& u) const {
        const long L = (long)i * G + c; if (L >= nwg) return false;
        int wgid = (int)L; { const int q = nwg / NXCD, r = nwg % NXCD, xcd = wgid % NXCD, off = wgid / NXCD; wgid = (xcd < r ? xcd * (q + 1) : r * (q + 1) + (xcd - r) * q) + off; }
        const int nig = WGM * nN, gid = wgid / nig, fm = gid * WGM, gsz = (nM - fm) < WGM ? (nM - fm) : WGM;
        u.pm = fm + ((wgid % nig) % gsz); u.pn = (wgid % nig) / gsz; return true;
    }
    __device__ __forceinline__ void a_ready(const Unit&) const {}
    __device__ __forceinline__ void done(const Unit&) const {}
};

__device__ __forceinline__ unsigned cvt_pk_bf16(float lo, float hi) { unsigned r; asm volatile("v_cvt_pk_bf16_f32 %0, %1, %2" : "=v"(r) : "v"(lo), "v"(hi)); return r; }

template <class Epi, class Sched, bool ALIGN_EPI = false, bool SP2 = false>
__device__ __forceinline__ void gemm_phase(PG8_LAS unsigned char* lds, const Gemm g, const Sched& S, const Epi& E, const int tid) {
    const int wid = __builtin_amdgcn_readfirstlane(tid >> 6), lane = tid & 63, wr = wid >> 2, wc = wid & 3, fr = lane & 15, fq = lane >> 4;
    const int K = g.K, nt = K / BK;
    unsigned voffA[2], voffB[2];
#pragma unroll
    for (int i = 0; i < 2; ++i) { int R, C; stage_rc(tid * 16 + i * 8192, R, C);
        voffA[i] = (unsigned)(R * K + C) * 2u; voffB[i] = (unsigned)(R * K + C) * 2u; }
    const size_t kstep = (size_t)(BK * 2);
    const size_t hstep = (size_t)HALF * K * 2;
    const size_t tstep = 2 * hstep;
    const unsigned ldsw = (unsigned)wid * 1024u;
    const int aoff = lds_byte(wr * 64 + fr, fq * 8), boff = lds_byte(wc * 32 + fr, fq * 8);
#define PG8_SA(b, h) (((b) * 2 + (h)) * HTB)
#define PG8_SB(b, h) ((4 + (b) * 2 + (h)) * HTB)
#define PG8_STAGE(bufoff, gbase, voff) do { _Pragma("unroll") for (int _i = 0; _i < 2; ++_i) \
        __builtin_amdgcn_global_load_lds((const unsigned*)((const char*)(gbase) + (voff)[_i]), (PG8_LAS unsigned*)(lds + (bufoff) + ldsw + _i * 8192), 16, 0, 0); } while (0)
#define PG8_LDA(dst, b, h) do { _Pragma("unroll") for (int m = 0; m < 4; ++m) _Pragma("unroll") for (int k = 0; k < 2; ++k) dst[m][k] = *(const PG8_LAS bf16x8*)(lds + PG8_SA(b, h) + aoff + m * 2048 + k * 1024); } while (0)
#define PG8_LDB(dst, b, h) do { _Pragma("unroll") for (int n = 0; n < 2; ++n) _Pragma("unroll") for (int k = 0; k < 2; ++k) dst[n][k] = *(const PG8_LAS bf16x8*)(lds + PG8_SB(b, h) + boff + n * 2048 + k * 1024); } while (0)
#define PG8_MMA(ai, bj, At, Bt) do { __builtin_amdgcn_s_setprio(1); _Pragma("unroll") for (int m = 0; m < 4; ++m) _Pragma("unroll") for (int n = 0; n < 2; ++n) _Pragma("unroll") for (int k = 0; k < 2; ++k) \
        acc[ai][bj][m][n] = __builtin_amdgcn_mfma_f32_16x16x32_bf16(Bt[n][k], At[m][k], acc[ai][bj][m][n], 0, 0, 0); __builtin_amdgcn_s_setprio(0); } while (0)
#define PG8_WAIT_V(n) asm volatile("s_waitcnt vmcnt(" #n ")" ::: "memory")
#define PG8_WAIT_L(n) asm volatile("s_waitcnt lgkmcnt(" #n ")" ::: "memory")
#define PG8_BAR __builtin_amdgcn_s_barrier()
#define PG8_SCHED __builtin_amdgcn_sched_barrier(0)
    Unit cur, nxt; int ui = 0;
    if (!S.next(0, cur)) return;
    f32x4 acc[2][2][4][2];
#pragma unroll
    for (int a = 0; a < 2; ++a)
#pragma unroll
        for (int b = 0; b < 2; ++b)
#pragma unroll
            for (int m = 0; m < 4; ++m)
#pragma unroll
                for (int n = 0; n < 2; ++n) acc[a][b][m][n] = (f32x4){0.f, 0.f, 0.f, 0.f};
    bf16x8 At[4][2], B0[2][2], B1[2][2];
    const char* cA = (const char*)g.A + (size_t)cur.pm * tstep; const char* cB = (const char*)g.Bt + (size_t)cur.pn * tstep;
    S.a_ready(cur);
    if constexpr (SP2) {
        PG8_STAGE(PG8_SB(0, 0), cB, voffB); PG8_STAGE(PG8_SB(0, 1), cB + hstep, voffB); PG8_STAGE(PG8_SA(0, 0), cA, voffA); PG8_STAGE(PG8_SA(0, 1), cA + hstep, voffA);
        if (wr == 1) PG8_BAR;
        PG8_WAIT_V(2); PG8_BAR;
        PG8_STAGE(PG8_SB(1, 0), cB + kstep, voffB); PG8_STAGE(PG8_SA(1, 0), cA + kstep, voffA); PG8_STAGE(PG8_SB(1, 1), cB + hstep + kstep, voffB);
        PG8_WAIT_V(6); PG8_BAR;
    } else {
        PG8_STAGE(PG8_SB(0, 0), cB, voffB); PG8_STAGE(PG8_SA(0, 0), cA, voffA); PG8_STAGE(PG8_SB(0, 1), cB + hstep, voffB); PG8_STAGE(PG8_SA(0, 1), cA + hstep, voffA);
        if (wr == 1) PG8_BAR;
        PG8_WAIT_V(4); PG8_BAR;
        PG8_STAGE(PG8_SB(1, 0), cB + kstep, voffB); PG8_STAGE(PG8_SA(1, 0), cA + kstep, voffA); PG8_STAGE(PG8_SB(1, 1), cB + hstep + kstep, voffB);
        PG8_WAIT_V(6); PG8_BAR;
    }
    for (;;) {
        const bool has_next = S.next(ui + 1, nxt);
        const char* nA = has_next ? (const char*)g.A + (size_t)nxt.pm * tstep : cA; const char* nB = has_next ? (const char*)g.Bt + (size_t)nxt.pn * tstep : cB;
        for (int t = 0; t < nt; t += 2) {
            const bool last = (t == nt - 2);
            const char* a1 = cA + (size_t)(t + 1) * kstep;
            const char* a2 = last ? nA : cA + (size_t)(t + 2) * kstep; const char* b2 = last ? nB : cB + (size_t)(t + 2) * kstep;
            const char* a3 = a2 + kstep; const char* b3 = b2 + kstep;
            if (last && has_next) S.a_ready(nxt);
            if constexpr (SP2) {
            PG8_LDB(B0, 0, 0); PG8_LDB(B1, 0, 1); PG8_SCHED; PG8_LDA(At, 0, 0); PG8_STAGE(PG8_SA(1, 1), a1 + hstep, voffA);
            PG8_WAIT_V(8); PG8_WAIT_L(0); PG8_BAR; PG8_MMA(0, 0, At, B0); PG8_MMA(0, 1, At, B1); PG8_BAR; PG8_SCHED;
            PG8_LDA(At, 0, 1); PG8_STAGE(PG8_SB(0, 0), b2, voffB); PG8_STAGE(PG8_SB(0, 1), b2 + hstep, voffB); PG8_STAGE(PG8_SA(0, 0), a2, voffA);
            PG8_WAIT_V(8); PG8_WAIT_L(0); PG8_BAR; PG8_MMA(1, 0, At, B0); PG8_MMA(1, 1, At, B1); PG8_BAR; PG8_SCHED;
            PG8_LDB(B0, 1, 0); PG8_LDB(B1, 1, 1); PG8_SCHED; PG8_LDA(At, 1, 0); PG8_STAGE(PG8_SA(0, 1), a2 + hstep, voffA);
            PG8_WAIT_V(8); PG8_WAIT_L(0); PG8_BAR; PG8_MMA(0, 0, At, B0); PG8_MMA(0, 1, At, B1); PG8_BAR; PG8_SCHED;
            PG8_LDA(At, 1, 1); PG8_STAGE(PG8_SB(1, 0), b3, voffB); PG8_STAGE(PG8_SB(1, 1), b3 + hstep, voffB); PG8_STAGE(PG8_SA(1, 0), a3, voffA);
            PG8_WAIT_V(8); PG8_WAIT_L(0); PG8_BAR; PG8_MMA(1, 0, At, B0); PG8_MMA(1, 1, At, B1); PG8_BAR; PG8_SCHED;
            } else {
            PG8_LDB(B0, 0, 0); PG8_SCHED; PG8_LDA(At, 0, 0); PG8_STAGE(PG8_SA(1, 1), a1 + hstep, voffA);
            PG8_WAIT_L(8); PG8_BAR; PG8_WAIT_L(0); PG8_MMA(0, 0, At, B0); PG8_BAR; PG8_SCHED;
            PG8_LDB(B1, 0, 1); PG8_STAGE(PG8_SB(0, 0), b2, voffB);
            PG8_BAR; PG8_WAIT_L(0); PG8_MMA(0, 1, At, B1); PG8_BAR;
            PG8_LDA(At, 0, 1); PG8_STAGE(PG8_SA(0, 0), a2, voffA);
            PG8_BAR; PG8_WAIT_L(0); PG8_MMA(1, 0, At, B0); PG8_BAR; PG8_SCHED;
            PG8_STAGE(PG8_SB(0, 1), b2 + hstep, voffB);
            PG8_WAIT_V(6); PG8_BAR; PG8_MMA(1, 1, At, B1); PG8_BAR;
            PG8_LDB(B0, 1, 0); PG8_SCHED; PG8_LDA(At, 1, 0); PG8_STAGE(PG8_SA(0, 1), a2 + hstep, voffA);
            PG8_WAIT_L(8); PG8_BAR; PG8_WAIT_L(0); PG8_MMA(0, 0, At, B0); PG8_BAR; PG8_SCHED;
            PG8_LDB(B1, 1, 1); PG8_STAGE(PG8_SB(1, 0), b3, voffB);
            PG8_BAR; PG8_WAIT_L(0); PG8_MMA(0, 1, At, B1); PG8_BAR;
            PG8_LDA(At, 1, 1); PG8_STAGE(PG8_SA(1, 0), a3, voffA);
            PG8_BAR; PG8_WAIT_L(0); PG8_MMA(1, 0, At, B0); PG8_BAR; PG8_SCHED;
            PG8_STAGE(PG8_SB(1, 1), b3 + hstep, voffB);
            PG8_WAIT_V(6); PG8_BAR; PG8_MMA(1, 1, At, B1); PG8_BAR;
            }
        }
        if constexpr (ALIGN_EPI) { if (wr == 0) PG8_BAR; }
        E(acc, cur, wr, wc, fr, fq); S.done(cur);
        if (!has_next) break;
#pragma unroll
        for (int a = 0; a < 2; ++a)
#pragma unroll
            for (int b = 0; b < 2; ++b)
#pragma unroll
                for (int m = 0; m < 4; ++m)
#pragma unroll
                    for (int n = 0; n < 2; ++n) acc[a][b][m][n] = (f32x4){0.f, 0.f, 0.f, 0.f};
        cur = nxt; cA = nA; cB = nB; ++ui;
        if constexpr (ALIGN_EPI) { if (wr == 1) PG8_BAR; }
    }
    PG8_WAIT_V(0);
    if constexpr (!ALIGN_EPI) { if (wr == 0) PG8_BAR; }
    PG8_BAR;
#undef PG8_SA
#undef PG8_SB
#undef PG8_STAGE
#undef PG8_LDA
#undef PG8_LDB
#undef PG8_MMA
#undef PG8_WAIT_V
#undef PG8_WAIT_L
#undef PG8_BAR
#undef PG8_SCHED
}
}

constexpr int D = 2048, NCTX = 8192, NLAT = 4096, MTOK = NCTX + NLAT;
constexpr int DEPTH = 2, NH = 16, HD = 64, ATTW = 1024, SSMW = 512, POOLW = 512, INW = 4096, FFH = 5632;
constexpr int SEQ = 256, DSEQ = 2048, PAST = 512, GW = 64;
constexpr float RMS_EPS = 1e-6f;
constexpr float LOG2E = 1.4426950408889634f;
constexpr float QSCALE = 0.125f * LOG2E;

constexpr size_t OUT_YP = 0, OUT_YS = (size_t)NCTX * D, OUT_CK = OUT_YS + (size_t)NLAT * D, OUT_CV = OUT_CK + (size_t)32 * 2 * 16 * 256 * 64, OUT_ST = OUT_CV + (size_t)32 * 2 * 16 * 256 * 64;

constexpr size_t MiB = 1u << 20;
constexpr size_t WS_CTL = 0, CTL_ZERO_BYTES = 1 * MiB;
constexpr size_t WS_MODP = 1 * MiB;
constexpr size_t WS_MODF = 6 * MiB;
constexpr size_t WS_KC = 8 * MiB;
constexpr size_t WS_CVT = 12 * MiB;
constexpr size_t WS_WIN = 16 * MiB;
constexpr size_t WS_WOUT = 48 * MiB;
constexpr size_t WS_WFI = 64 * MiB;
constexpr size_t WS_WFO = 152 * MiB;
constexpr size_t WS_WGLU = 196 * MiB;
constexpr size_t WS_H = 200 * MiB;
constexpr size_t WS_QH = 248 * MiB, WS_KH = 272 * MiB, WS_VT = 296 * MiB;
constexpr size_t WS_UB = 320 * MiB, WS_PB = 344 * MiB, WS_YF = 368 * MiB, WS_YB = 392 * MiB;
constexpr size_t WS_YA = 416 * MiB;
constexpr size_t WS_CAT = 428 * MiB;
constexpr size_t WS_XA = 476 * MiB;
constexpr size_t WS_HID = 572 * MiB;
constexpr size_t WS_END = 704 * MiB;
constexpr int CW_BAR = 4096;

constexpr int RING_BYTES = 131072;
constexpr int LDSCTL_OFF = 139264, MISC_OFF = LDSCTL_OFF + 320;
constexpr int LDS_BYTES = 147456;

#define GAS __attribute__((address_space(1)))
#define LAS __attribute__((address_space(3)))
typedef unsigned short bf16;
typedef unsigned v4u __attribute__((ext_vector_type(4)));
typedef unsigned v2u __attribute__((ext_vector_type(2)));
typedef float f32x4 __attribute__((ext_vector_type(4)));
typedef float f32x2 __attribute__((ext_vector_type(2)));
typedef short bf16x8 __attribute__((ext_vector_type(8)));
#define LDS_WAIT() asm volatile("s_waitcnt lgkmcnt(0)" ::: "memory")
#define VM_WAIT() asm volatile("s_waitcnt vmcnt(0)" ::: "memory")
__device__ __forceinline__ unsigned f2bf(float f) { unsigned u = __builtin_bit_cast(unsigned, f); return (u + 0x7fffu + ((u >> 16) & 1u)) >> 16; }
__device__ __forceinline__ unsigned pk2(float lo, float hi) { return pg8::cvt_pk_bf16(lo, hi); }

#define XB_TMO      128
#define XB_XCNT(j)  (256  + 64 * (j))
#define XB_XSUB(j)  (1280 + 64 * (j))
#define XB_XGEN(j)  (2304 + 64 * (j))
#define XB_TOP      3328
#define XB_TOPGEN   3392
#define XCD_BAR_WORDS 3456
#define XB_SPIN_CAP (1u << 18)
__device__ __forceinline__ unsigned xb_ld(unsigned* p)              { return __hip_atomic_load(p, __ATOMIC_RELAXED, __HIP_MEMORY_SCOPE_AGENT); }
__device__ __forceinline__ unsigned xb_add(unsigned* p, unsigned v) { return __hip_atomic_fetch_add(p, v, __ATOMIC_RELAXED, __HIP_MEMORY_SCOPE_AGENT); }
__device__ __forceinline__ unsigned xb_xcc_id() { return (unsigned)__builtin_amdgcn_s_getreg((3 << 11) | 20) & 0xFu; }
#define XB_SPIN(cond, bar) do { unsigned _sp = 0; while (cond) { __builtin_amdgcn_s_sleep(1); \
    if ((++_sp & 255u) == 0u) { if (xb_ld(&(bar)[XB_TMO])) break; if (_sp > XB_SPIN_CAP) { atomicAdd(&(bar)[XB_TMO], 1u); break; } } } } while (0)
struct XcdBarrier { unsigned* bar; unsigned x; volatile LAS unsigned* st; };
__device__ __forceinline__ XcdBarrier xcd_barrier_post(unsigned* bar, volatile LAS unsigned* st) {
    XcdBarrier b; b.bar = bar; b.x = xb_xcc_id(); b.st = st;
    if (threadIdx.x == 0) (void)xb_add(&bar[XB_XCNT(b.x)], 1u);
    return b;
}
__device__ __forceinline__ void xcd_barrier_complete(unsigned* bar, unsigned x, unsigned& nloc, unsigned& nx) {
    const unsigned G = gridDim.x * gridDim.y * gridDim.z;
    unsigned sum, cnt, mine, sp = 0u;
    for (;;) {
        sum = 0u; cnt = 0u; mine = 0u;
#pragma unroll
        for (unsigned j = 0; j < 16; ++j) { const unsigned c = xb_ld(&bar[XB_XCNT(j)]); sum += c; cnt += (c > 0u) ? 1u : 0u; mine = (j == x) ? c : mine; }
        if (sum == G) break;
        __builtin_amdgcn_s_sleep(1);
        if ((++sp & 255u) == 0u) { if (xb_ld(&bar[XB_TMO])) break; if (sp > XB_SPIN_CAP) { atomicAdd(&bar[XB_TMO], 1u); break; } }
    }
    nloc = mine > 0u ? mine : 1u; nx = cnt > 0u ? cnt : 1u;
}
__device__ __forceinline__ void xcd_barrier(const XcdBarrier& b) {
    asm volatile("s_waitcnt vmcnt(0)" ::: "memory");
    __syncthreads();
    if (threadIdx.x == 0) {
        unsigned* bar = b.bar;
        __builtin_amdgcn_s_waitcnt(0);
        unsigned nloc = b.st[0], nx = b.st[1];
        if (nloc == 0u) { xcd_barrier_complete(bar, b.x, nloc, nx); b.st[0] = nloc; b.st[1] = nx; }
        const unsigned old = xb_add(&bar[XB_XSUB(b.x)], 1u);
        const unsigned gen = old / nloc;
        if (old + 1u == (gen + 1u) * nloc) {
            __builtin_amdgcn_fence(__ATOMIC_RELEASE, "agent");
            asm volatile("s_waitcnt vmcnt(0)" ::: "memory");
            const unsigned og = xb_add(&bar[XB_TOP], 1u);
            const unsigned tg = og / nx;
            if (og + 1u == (tg + 1u) * nx) xb_add(&bar[XB_TOPGEN], 1u);
            else XB_SPIN(xb_ld(&bar[XB_TOPGEN]) == tg, bar);
            __builtin_amdgcn_fence(__ATOMIC_ACQUIRE, "agent");
            xb_add(&bar[XB_XGEN(b.x)], 1u);
            asm volatile("s_waitcnt vmcnt(0)" ::: "memory");
        } else {
            XB_SPIN(xb_ld(&bar[XB_XGEN(b.x)]) == gen, bar);
            __builtin_amdgcn_fence(__ATOMIC_ACQUIRE, "agent");
            asm volatile("s_waitcnt vmcnt(0)" ::: "memory");
        }
    }
    __syncthreads();
}

struct Args { const float* in[29]; float* out; unsigned char* ws; int ph_lo, ph_hi; };
enum { I_XP = 0, I_XS, I_C, I_CK, I_CV, I_ST, I_CCTX, I_WMOD, I_BMOD, I_N1G, I_N2G, I_WIN, I_RPB, I_ARE, I_AIM, I_LDT, I_BRE, I_BIM, I_CRE, I_CIM, I_SD, I_WGLU, I_BGLU,
       I_POOLW, I_POOLS, I_WOUT, I_WFI, I_WFO, I_FNG };

__device__ __forceinline__ float wave_sum(float v) {
#pragma unroll
    for (int o = 1; o < 64; o <<= 1) v += __shfl_xor(v, o);
    return v;
}
__device__ __forceinline__ int invperm32(int s) { return 16 * ((s >> 2) & 1) + 4 * (s >> 3) + (s & 3); }
__device__ __forceinline__ int bt_row(int s, int kind, int HS) {
    int d = s;
    if (kind == 1) { const int half = s >= HS ? 1 : 0; const int j = s - half * HS; d = (j >> 7) * 256 + half * 128 + (j & 127); }
    return (d & ~31) + invperm32(d & 31);
}
__device__ __forceinline__ size_t hrow(int row, int h) {
    if (row < NCTX) return ((size_t)((row >> 8) * 16 + h) << 8) + (size_t)(row & 255);
    const int r = row - NCTX; return (size_t)NCTX * 16 + ((size_t)((r >> 11) * 16 + h) << 11) + (size_t)(r & 2047);
}
__device__ __forceinline__ size_t vtidx(int row, int h, int d) {
    if (row < NCTX) return (((size_t)((row >> 8) * 16 + h) * 64 + d) << 8) + (size_t)(row & 255);
    const int r = row - NCTX; return (size_t)NCTX * 1024 + (((size_t)((r >> 11) * 16 + h) * 64 + d) << 11) + (size_t)(r & 2047);
}
__device__ __forceinline__ int cond_of_row(int row) { return row < NCTX ? 0 : 1 + ((row - NCTX) >> 11); }

__device__ __forceinline__ void transpose_item(const float* W, int ldw, int K, bf16* WT, int kind, int HS, LAS float* scr, int kb, int nb, int lane) {
    const int k0 = 64 * kb, n0 = 64 * nb;
    f32x4 v[16];
#pragma unroll
    for (int i = 0; i < 16; ++i) { const int kk = 4 * i + (lane >> 4); v[i] = *(const f32x4*)(W + (size_t)(k0 + kk) * ldw + n0 + 4 * (lane & 15)); }
#pragma unroll
    for (int i = 0; i < 16; ++i) { const int kk = 4 * i + (lane >> 4); LAS float* s = scr + kk * 65 + 4 * (lane & 15); s[0] = v[i][0]; s[1] = v[i][1]; s[2] = v[i][2]; s[3] = v[i][3]; }
    LDS_WAIT(); asm volatile("" ::: "memory");
    const int c = lane & 7;
#pragma unroll
    for (int j = 0; j < 8; ++j) { const int n = (lane >> 3) + 8 * j; const LAS float* s = scr + (8 * c) * 65 + n;
        v4u o; o.x = pk2(s[0 * 65], s[1 * 65]); o.y = pk2(s[2 * 65], s[3 * 65]); o.z = pk2(s[4 * 65], s[5 * 65]); o.w = pk2(s[6 * 65], s[7 * 65]);
        const int dr = bt_row(n0 + n, kind, HS);
        *(v4u*)(WT + (size_t)dr * K + k0 + 8 * c) = o; }
    LDS_WAIT(); asm volatile("" ::: "memory");
}
__device__ __forceinline__ void fold_item(const float* win_l, const float* pw_l, const float* ps_l, bf16* WT, int g, int kb, int lane) {
    const int k0 = 8 * kb;
    float a0[8], a1[8];
#pragma unroll
    for (int k = 0; k < 8; ++k) { a0[k] = 0.f; a1[k] = 0.f; }
    const float* wg = pw_l + (size_t)g * 128 * 128;
    for (int c = 0; c < 128; ++c) {
        const float b0 = wg[c * 128 + lane], b1 = wg[c * 128 + 64 + lane];
#pragma unroll
        for (int k = 0; k < 8; ++k) { const float a = win_l[(size_t)(k0 + k) * INW + 3584 + 128 * g + c]; a0[k] += a * b0; a1[k] += a * b1; }
    }
    const float s0 = ps_l[128 * g + lane], s1 = ps_l[128 * g + 64 + lane];
    v4u o0, o1;
    o0.x = pk2(a0[0] * s0, a0[1] * s0); o0.y = pk2(a0[2] * s0, a0[3] * s0); o0.z = pk2(a0[4] * s0, a0[5] * s0); o0.w = pk2(a0[6] * s0, a0[7] * s0);
    o1.x = pk2(a1[0] * s1, a1[1] * s1); o1.y = pk2(a1[2] * s1, a1[3] * s1); o1.z = pk2(a1[4] * s1, a1[5] * s1); o1.w = pk2(a1[6] * s1, a1[7] * s1);
    *(v4u*)(WT + (size_t)bt_row(3584 + 128 * g + lane, 0, 0) * D + k0) = o0;
    *(v4u*)(WT + (size_t)bt_row(3584 + 128 * g + 64 + lane, 0, 0) * D + k0) = o1;
}
__device__ __forceinline__ void modp_item(const float* wmod, const float* cvec, const float* cctx, float* modp, int l, int kc, int wcol, int lane) {
    const int col4 = wcol * 64 + lane;
    f32x4 a0 = {0.f, 0.f, 0.f, 0.f}, a1 = a0, a2 = a0;
    const float* wp = wmod + ((size_t)l * D + (size_t)kc * 128) * (6 * D) + 4 * col4;
#pragma unroll 8
    for (int k = 0; k < 128; ++k) {
        const int kk = kc * 128 + k;
        const f32x4 w = *(const f32x4*)(wp + (size_t)k * (6 * D));
        const float c0 = cctx[kk], c1 = cvec[kk], c2 = cvec[D + kk];
        const float s0 = c0 / (1.f + __expf(-c0)), s1 = c1 / (1.f + __expf(-c1)), s2 = c2 / (1.f + __expf(-c2));
        a0 += w * s0; a1 += w * s1; a2 += w * s2;
    }
    float* o = modp + ((size_t)(l * 16 + kc) * 3) * (6 * D) + 4 * col4;
    *(f32x4*)(o) = a0; *(f32x4*)(o + 6 * D) = a1; *(f32x4*)(o + 12 * D) = a2;
}

__device__ __forceinline__ void norm_row(const float* xrow, const float* gain, const float* shv, const float* scv, bf16* obf, float* of32, int lane) {
    f32x4 v[8]; float s = 0.f;
#pragma unroll
    for (int j = 0; j < 8; ++j) { v[j] = *(const f32x4*)(xrow + 4 * (64 * j + lane)); s += (v[j][0] * v[j][0] + v[j][1] * v[j][1]) + (v[j][2] * v[j][2] + v[j][3] * v[j][3]); }
    const float rstd = 1.0f / sqrtf(wave_sum(s) * (1.f / D) + RMS_EPS);
#pragma unroll
    for (int j = 0; j < 8; ++j) {
        const int c = 4 * (64 * j + lane);
        const f32x4 g = *(const f32x4*)(gain + c);
        f32x4 y = v[j] * rstd * g;
        if (obf) {
            const f32x4 sc = *(const f32x4*)(scv + c), sh = *(const f32x4*)(shv + c);
            y = y * (sc + 1.0f) + sh;
            v2u o; o.x = pk2(y[0], y[1]); o.y = pk2(y[2], y[3]);
            *(v2u*)(obf + c) = o;
        } else {
            *(f32x4*)(of32 + c) = y;
        }
    }
}

using pg8::Unit;
struct EpiIn {
    bf16 *qh, *kh, *vt; float *ub, *pb, *outk, *outv; int layer;
    static constexpr bool PERM = false, AFTER_DRAIN = false;
    __device__ __forceinline__ void operator()(const f32x4 (&acc)[2][2][4][2], const Unit& u, int wr, int wc, int fr, int fq) const {
        const int pn = u.pn, seg = pn >> 2;
#pragma unroll
        for (int ai = 0; ai < 2; ++ai)
#pragma unroll
            for (int m = 0; m < 4; ++m) {
                const int row = u.pm * 256 + ai * 128 + wr * 64 + m * 16 + fr;
#pragma unroll
                for (int bj = 0; bj < 2; ++bj) {
                    const f32x4 v0 = acc[ai][bj][m][0], v1 = acc[ai][bj][m][1];
                    const int cl = (pn & 3) * 256 + bj * 128 + wc * 32 + 8 * fq;
                    if (seg == 0) {
                        const int h = cl >> 6, d = cl & 63;
                        v4u w; w.x = pk2(v0[0] * QSCALE, v0[1] * QSCALE); w.y = pk2(v0[2] * QSCALE, v0[3] * QSCALE); w.z = pk2(v1[0] * QSCALE, v1[1] * QSCALE); w.w = pk2(v1[2] * QSCALE, v1[3] * QSCALE);
                        *(v4u*)(qh + hrow(row, h) * 64 + d) = w;
                    } else if (seg == 1) {
                        const int h = cl >> 6, d = cl & 63;
                        v4u w; w.x = pk2(v0[0], v0[1]); w.y = pk2(v0[2], v0[3]); w.z = pk2(v1[0], v1[1]); w.w = pk2(v1[2], v1[3]);
                        *(v4u*)(kh + hrow(row, h) * 64 + d) = w;
                        if (row < NCTX) { float* o = outk + ((((size_t)(row >> 8) * 2 + layer) * 16 + h) * 256 + (row & 255)) * 64 + d; *(f32x4*)o = v0; *(f32x4*)(o + 4) = v1; }
                    } else if (seg == 2) {
                        const int h = cl >> 6, d = cl & 63;
                        const size_t b0 = vtidx(row, h, d); const size_t st = row < NCTX ? 256 : 2048;
                        vt[b0] = (bf16)f2bf(v0[0]); vt[b0 + st] = (bf16)f2bf(v0[1]); vt[b0 + 2 * st] = (bf16)f2bf(v0[2]); vt[b0 + 3 * st] = (bf16)f2bf(v0[3]);
                        vt[b0 + 4 * st] = (bf16)f2bf(v1[0]); vt[b0 + 5 * st] = (bf16)f2bf(v1[1]); vt[b0 + 6 * st] = (bf16)f2bf(v1[2]); vt[b0 + 7 * st] = (bf16)f2bf(v1[3]);
                        if (row < NCTX) { float* o = outv + ((((size_t)(row >> 8) * 2 + layer) * 16 + h) * 256 + (row & 255)) * 64 + d; *(f32x4*)o = v0; *(f32x4*)(o + 4) = v1; }
                    } else {
                        float* o = (cl < 512 ? ub + (size_t)row * 512 + cl : pb + (size_t)row * 512 + (cl - 512));
                        *(f32x4*)o = v0; *(f32x4*)(o + 4) = v1;
                    }
                }
            }
    }
};
struct EpiGlu {
    bf16* cat; const float* bias;
    static constexpr bool PERM = false, AFTER_DRAIN = false;
    __device__ __forceinline__ void operator()(const f32x4 (&acc)[2][2][4][2], const Unit& u, int wr, int wc, int fr, int fq) const {
        const int j0 = u.pn * 128 + wc * 32 + 8 * fq;
        const f32x4 bv0 = *(const f32x4*)(bias + j0), bv1 = *(const f32x4*)(bias + j0 + 4), bg0 = *(const f32x4*)(bias + 512 + j0), bg1 = *(const f32x4*)(bias + 512 + j0 + 4);
#pragma unroll
        for (int ai = 0; ai < 2; ++ai)
#pragma unroll
            for (int m = 0; m < 4; ++m) {
                const int row = u.pm * 256 + ai * 128 + wr * 64 + m * 16 + fr;
                const f32x4 a0 = acc[ai][0][m][0] + bv0, a1 = acc[ai][0][m][1] + bv1, g0 = acc[ai][1][m][0] + bg0, g1 = acc[ai][1][m][1] + bg1;
                float r[8];
#pragma unroll
                for (int i = 0; i < 4; ++i) { r[i] = a0[i] / (1.f + __expf(-g0[i])); r[4 + i] = a1[i] / (1.f + __expf(-g1[i])); }
                v4u w; w.x = pk2(r[0], r[1]); w.y = pk2(r[2], r[3]); w.z = pk2(r[4], r[5]); w.w = pk2(r[6], r[7]);
                *(v4u*)(cat + (size_t)row * D + 1024 + j0) = w;
            }
    }
};
struct EpiRes {
    const float* xin_ctx; const float* xin_lat; float* xo; const float* gate;
    static constexpr bool PERM = false, AFTER_DRAIN = false;
    __device__ __forceinline__ void operator()(const f32x4 (&acc)[2][2][4][2], const Unit& u, int wr, int wc, int fr, int fq) const {
        const int row0 = u.pm * 256;
        const float* gp = gate + (size_t)cond_of_row(row0) * (6 * D);
        const float* xi = row0 < NCTX ? xin_ctx + (size_t)row0 * D : xin_lat + (size_t)(row0 - NCTX) * D;
        float* xout = xo + (size_t)row0 * D;
#pragma unroll
        for (int bj = 0; bj < 2; ++bj) {
            const int col = u.pn * 256 + bj * 128 + wc * 32 + 8 * fq;
            const f32x4 g0 = *(const f32x4*)(gp + col), g1 = *(const f32x4*)(gp + col + 4);
#pragma unroll
            for (int ai = 0; ai < 2; ++ai)
#pragma unroll
                for (int m = 0; m < 4; ++m) {
                    const size_t off = (size_t)(ai * 128 + wr * 64 + m * 16 + fr) * D + col;
                    const f32x4 x0 = *(const f32x4*)(xi + off), x1 = *(const f32x4*)(xi + off + 4);
                    *(f32x4*)(xout + off) = x0 + g0 * acc[ai][bj][m][0];
                    *(f32x4*)(xout + off + 4) = x1 + g1 * acc[ai][bj][m][1];
                }
        }
    }
};
struct EpiSwi {
    bf16* hid;
    static constexpr bool PERM = false, AFTER_DRAIN = false;
    __device__ __forceinline__ void operator()(const f32x4 (&acc)[2][2][4][2], const Unit& u, int wr, int wc, int fr, int fq) const {
        const int j0 = u.pn * 128 + wc * 32 + 8 * fq;
#pragma unroll
        for (int ai = 0; ai < 2; ++ai)
#pragma unroll
            for (int m = 0; m < 4; ++m) {
                const int row = u.pm * 256 + ai * 128 + wr * 64 + m * 16 + fr;
                const f32x4 g0 = acc[ai][0][m][0], g1 = acc[ai][0][m][1], u0 = acc[ai][1][m][0], u1 = acc[ai][1][m][1];
                float r[8];
#pragma unroll
                for (int i = 0; i < 4; ++i) { r[i] = g0[i] / (1.f + __expf(-g0[i])) * u0[i]; r[4 + i] = g1[i] / (1.f + __expf(-g1[i])) * u1[i]; }
                v4u w; w.x = pk2(r[0], r[1]); w.y = pk2(r[2], r[3]); w.z = pk2(r[4], r[5]); w.w = pk2(r[6], r[7]);
                *(v4u*)(hid + (size_t)row * FFH + j0) = w;
            }
    }
};

#define MFMA16(a, b, c) __builtin_amdgcn_mfma_f32_16x16x32_bf16((a), (b), (c), 0, 0, 0)
template <bool LOCAL, class KP, class VP, class BIAS>
__device__ __forceinline__ void attn_chunk(const bf16x8 (&qf)[2], const KP& kp, const VP& vp, const BIAS& biasf, float& m_run, float& l_run, f32x4 (&o)[4]) {
    f32x4 s[8][2];
#pragma unroll
    for (int p = 0; p < 8; ++p)
#pragma unroll
        for (int blk = 0; blk < 2; ++blk) {
            const bf16* kr = kp(p, blk);
            const bf16x8 a0 = *(const bf16x8*)(kr), a1 = *(const bf16x8*)(kr + 32);
            f32x4 z = {0.f, 0.f, 0.f, 0.f};
            z = MFMA16(a0, qf[0], z); z = MFMA16(a1, qf[1], z);
            s[p][blk] = z;
        }
    if (LOCAL) {
#pragma unroll
        for (int p = 0; p < 8; ++p)
#pragma unroll
            for (int blk = 0; blk < 2; ++blk)
#pragma unroll
                for (int r = 0; r < 4; ++r) s[p][blk][r] = biasf(p, blk, r, s[p][blk][r]);
    }
    float mx = s[0][0][0];
#pragma unroll
    for (int p = 0; p < 8; ++p)
#pragma unroll
        for (int blk = 0; blk < 2; ++blk)
#pragma unroll
            for (int r = 0; r < 4; ++r) mx = fmaxf(mx, s[p][blk][r]);
    mx = fmaxf(mx, __shfl_xor(mx, 16)); mx = fmaxf(mx, __shfl_xor(mx, 32));
    const float m_new = fmaxf(m_run, mx);
    const float alpha = __builtin_amdgcn_exp2f(m_run - m_new);
    l_run *= alpha;
#pragma unroll
    for (int db = 0; db < 4; ++db) o[db] = o[db] * alpha;
    m_run = m_new;
    float ls = 0.f;
    bf16x8 pb[8];
#pragma unroll
    for (int p = 0; p < 8; ++p) {
        float e[8];
#pragma unroll
        for (int blk = 0; blk < 2; ++blk)
#pragma unroll
            for (int r = 0; r < 4; ++r) { e[blk * 4 + r] = __builtin_amdgcn_exp2f(s[p][blk][r] - m_new); ls += e[blk * 4 + r]; }
        v4u w; w.x = pk2(e[0], e[1]); w.y = pk2(e[2], e[3]); w.z = pk2(e[4], e[5]); w.w = pk2(e[6], e[7]);
        pb[p] = __builtin_bit_cast(bf16x8, w);
    }
    l_run += ls;
#pragma unroll
    for (int p = 0; p < 8; ++p)
#pragma unroll
        for (int db = 0; db < 4; ++db) {
            const bf16x8 vf = *(const bf16x8*)(vp(p, db));
            o[db] = MFMA16(vf, pb[p], o[db]);
        }
}
__device__ __forceinline__ void attn_store(bf16* cat, int qrow, int h, int g, float l_run, const f32x4 (&o)[4]) {
    float l = l_run; l += __shfl_xor(l, 16); l += __shfl_xor(l, 32);
    const float inv = 1.0f / l;
    bf16* op = cat + (size_t)qrow * D + h * 64 + 4 * g;
#pragma unroll
    for (int db = 0; db < 4; ++db) { v2u w; w.x = pk2(o[db][0] * inv, o[db][1] * inv); w.y = pk2(o[db][2] * inv, o[db][3] * inv); *(v2u*)(op + 16 * db) = w; }
}
__device__ __forceinline__ void attn_ctx_wave(const bf16* qh, const bf16* kh, const bf16* vt, bf16* cat, int b, int h, int qb, int lane) {
    const int i = lane & 15, g = lane >> 4;
    const size_t hb = ((size_t)(b * 16 + h)) << 8;
    const bf16* qp = qh + (hb + qb * 16 + i) * 64 + 8 * g;
    bf16x8 qf[2]; qf[0] = *(const bf16x8*)qp; qf[1] = *(const bf16x8*)(qp + 32);
    const bf16* kbase = kh + (hb + 8 * (i >> 2) + (i & 3)) * 64 + 8 * g;
    const bf16* vbase = vt + (((size_t)(b * 16 + h) * 64 + i) << 8) + 8 * g;
    float m_run = -INFINITY, l_run = 0.f; f32x4 o[4];
#pragma unroll
    for (int db = 0; db < 4; ++db) o[db] = (f32x4){0.f, 0.f, 0.f, 0.f};
    auto kp = [&](int p, int blk) { return kbase + (32 * p + 4 * blk) * 64; };
    auto vp = [&](int p, int db) { return vbase + (size_t)(16 * db) * 256 + 32 * p; };
    auto nb = [&](int, int, int, float v) { return v; };
    attn_chunk<false>(qf, kp, vp, nb, m_run, l_run, o);
    attn_store(cat, b * 256 + qb * 16 + i, h, g, l_run, o);
}
__device__ __forceinline__ void attn_lat_wave(const bf16* qh, const bf16* kh, const bf16* vt, const bf16* kc, const bf16* cvt, const float* rpb_lh, bf16* cat,
                                              int layer, int b, int h, int r, int cq, int lane) {
    const int i = lane & 15, g = lane >> 4;
    const int c0 = 16 * cq;
    const int cs0 = (cq == 0) ? 0 : (cq == 1) ? 8 : (cq == 2) ? 24 : 32;
    const int rs = min(max(r - 4, 0), 24);
    const size_t hb = (size_t)NCTX * 16 + (((size_t)(b * 16 + h)) << 11);
    const int tq = r * 64 + c0 + i;
    const bf16* qp = qh + (hb + tq) * 64 + 8 * g;
    bf16x8 qf[2]; qf[0] = *(const bf16x8*)qp; qf[1] = *(const bf16x8*)(qp + 32);
    float m_run = -INFINITY, l_run = 0.f; f32x4 o[4];
#pragma unroll
    for (int db = 0; db < 4; ++db) o[db] = (f32x4){0.f, 0.f, 0.f, 0.f};
    auto nb = [&](int, int, int, float v) { return v; };
    const size_t cb = ((size_t)(b * 2 + layer) * 16 + h);
    const bf16* ckbase = kc + (cb * 512 + 8 * (i >> 2) + (i & 3)) * 64 + 8 * g;
    const bf16* cvbase = cvt + (cb * 64 + i) * 512 + 8 * g;
#pragma unroll 1
    for (int ch = 0; ch < 2; ++ch) {
        auto kp = [&](int p, int blk) { return ckbase + (256 * ch + 32 * p + 4 * blk) * 64; };
        auto vp = [&](int p, int db) { return cvbase + (size_t)(16 * db) * 512 + 256 * ch + 32 * p; };
        attn_chunk<false>(qf, kp, vp, nb, m_run, l_run, o);
    }
    {
        const bf16* kbase = kh + (hb + (size_t)rs * 64 + cs0 + 8 * (i >> 2) + (i & 3)) * 64 + 8 * g;
        const bf16* vbase = vt + (size_t)NCTX * 1024 + (((size_t)(b * 16 + h) * 64 + i) << 11) + (size_t)rs * 64 + cs0 + 8 * g;
        auto kp = [&](int p, int blk) { return kbase + (64 * p + 4 * blk) * 64; };
        auto vp = [&](int p, int db) { return vbase + (size_t)(16 * db) * 2048 + 64 * p; };
        const int c = c0 + i;
        const int cst = min(max(c - 8, 0), 48);
        auto bf = [&](int p, int blk, int rr, float v) {
            const int kcol = cs0 + 8 * g + 4 * blk + rr;
            const int dr = rs + p - r + 7;
            const int dc = min(max(kcol - c, -15), 15) + 15;
            const float bias = rpb_lh[dr * 31 + dc] * LOG2E;
            return (kcol >= cst && kcol < cst + 16) ? v + bias : -1e30f;
        };
        attn_chunk<true>(qf, kp, vp, bf, m_run, l_run, o);
    }
    attn_store(cat, NCTX + b * 2048 + tq, h, g, l_run, o);
}

struct SsmPar { float are, aim; float bbr[16], bbi[16]; bf16x8 cf[4]; };
__device__ __forceinline__ void ssm_params(SsmPar& P, const Args& a, int layer, int dir, int g, int lane) {
    const int ldg = (layer * 2 + dir) * 32 + g;
    const float lre = a.in[I_ARE][(size_t)ldg * 64 + lane], lim = a.in[I_AIM][(size_t)ldg * 64 + lane];
    const float dt = expf(a.in[I_LDT][ldg]);
    const float mag = expf(lre * dt);
    float ang = lim * dt;
    const float kq = rintf(ang * 0.15915494309189535f);
    ang = fmaf(-kq, 6.2831854820251465f, ang); ang = fmaf(-kq, -1.7484555e-07f, ang);
    const float sn = sinf(ang), cs = cosf(ang);
    P.are = mag * cs; P.aim = mag * sn;
    const float xr = P.are - 1.0f, xi = P.aim, den = 1.0f / (lre * lre + lim * lim);
    const float cr = (xr * lre + xi * lim) * den, ci = (xi * lre - xr * lim) * den;
    const float* br = a.in[I_BRE] + ((size_t)ldg * 64 + lane) * 16; const float* bi = a.in[I_BIM] + ((size_t)ldg * 64 + lane) * 16;
#pragma unroll
    for (int q = 0; q < 4; ++q) {
        const f32x4 r4 = *(const f32x4*)(br + 4 * q), i4 = *(const f32x4*)(bi + 4 * q);
#pragma unroll
        for (int e = 0; e < 4; ++e) { P.bbr[4 * q + e] = cr * r4[e] - ci * i4[e]; P.bbi[4 * q + e] = cr * i4[e] + ci * r4[e]; }
    }
    const int m = lane & 15, gq = lane >> 4;
    const float* cre = a.in[I_CRE] + ((size_t)ldg * 16 + m) * 64; const float* cim = a.in[I_CIM] + ((size_t)ldg * 16 + m) * 64;
#pragma unroll
    for (int s = 0; s < 4; ++s) {
        const int p0 = 16 * s + 4 * gq;
        const f32x4 r4 = *(const f32x4*)(cre + p0), i4 = *(const f32x4*)(cim + p0);
        v4u w; w.x = pk2(r4[0], -i4[0]); w.y = pk2(r4[1], -i4[1]); w.z = pk2(r4[2], -i4[2]); w.w = pk2(r4[3], -i4[3]);
        P.cf[s] = __builtin_bit_cast(bf16x8, w);
    }
}
template <bool DO_Y>
__device__ __forceinline__ void ssm_scan256(const SsmPar& P, const float* ub, float* ybuf, int row0, int dir, int g, float& hr, float& hi, LAS float* ulds, LAS unsigned* hb, int lane) {
    const int col = lane & 15, gq = lane >> 4;
#pragma unroll 1
    for (int half = 0; half < 2; ++half) {
        const int tok_lo = dir ? 128 * (1 - half) : 128 * half;
        LDS_WAIT();
#pragma unroll
        for (int q = 0; q < 8; ++q) {
            const int j = 16 * q + (lane >> 2), c4 = lane & 3;
            const f32x4 v = *(const f32x4*)(ub + (size_t)(row0 + tok_lo + j) * 512 + g * 16 + 4 * c4);
            *(LAS f32x4*)(ulds + j * 16 + 4 * c4) = v;
        }
        LDS_WAIT(); asm volatile("" ::: "memory");
#pragma unroll 1
        for (int sb = 0; sb < 8; ++sb) {
#pragma unroll
            for (int i = 0; i < 16; ++i) {
                const int j = dir ? 127 - (16 * sb + i) : 16 * sb + i;
                const LAS f32x4* up = (const LAS f32x4*)(ulds + j * 16);
                const f32x4 u0 = up[0], u1 = up[1], u2 = up[2], u3 = up[3];
                float br0 = P.bbr[0] * u0[0], bi0 = P.bbi[0] * u0[0], br1 = P.bbr[1] * u0[1], bi1 = P.bbi[1] * u0[1];
                br0 = fmaf(P.bbr[2], u0[2], br0); bi0 = fmaf(P.bbi[2], u0[2], bi0); br1 = fmaf(P.bbr[3], u0[3], br1); bi1 = fmaf(P.bbi[3], u0[3], bi1);
                br0 = fmaf(P.bbr[4], u1[0], br0); bi0 = fmaf(P.bbi[4], u1[0], bi0); br1 = fmaf(P.bbr[5], u1[1], br1); bi1 = fmaf(P.bbi[5], u1[1], bi1);
                br0 = fmaf(P.bbr[6], u1[2], br0); bi0 = fmaf(P.bbi[6], u1[2], bi0); br1 = fmaf(P.bbr[7], u1[3], br1); bi1 = fmaf(P.bbi[7], u1[3], bi1);
                br0 = fmaf(P.bbr[8], u2[0], br0); bi0 = fmaf(P.bbi[8], u2[0], bi0); br1 = fmaf(P.bbr[9], u2[1], br1); bi1 = fmaf(P.bbi[9], u2[1], bi1);
                br0 = fmaf(P.bbr[10], u2[2], br0); bi0 = fmaf(P.bbi[10], u2[2], bi0); br1 = fmaf(P.bbr[11], u2[3], br1); bi1 = fmaf(P.bbi[11], u2[3], bi1);
                br0 = fmaf(P.bbr[12], u3[0], br0); bi0 = fmaf(P.bbi[12], u3[0], bi0); br1 = fmaf(P.bbr[13], u3[1], br1); bi1 = fmaf(P.bbi[13], u3[1], bi1);
                br0 = fmaf(P.bbr[14], u3[2], br0); bi0 = fmaf(P.bbi[14], u3[2], bi0); br1 = fmaf(P.bbr[15], u3[3], br1); bi1 = fmaf(P.bbi[15], u3[3], bi1);
                const float nr = fmaf(P.are, hr, fmaf(-P.aim, hi, br0 + br1));
                const float ni = fmaf(P.are, hi, fmaf(P.aim, hr, bi0 + bi1));
                hr = nr; hi = ni;
                if (DO_Y) hb[(j & 15) * 68 + lane] = pk2(hr, hi);
            }
            if (DO_Y) {
                LDS_WAIT(); asm volatile("" ::: "memory");
                f32x4 y = {0.f, 0.f, 0.f, 0.f};
#pragma unroll
                for (int s = 0; s < 4; ++s) {
                    const bf16x8 bfr = *(const LAS bf16x8*)((const LAS unsigned char*)hb + col * 272 + (32 * s + 8 * gq) * 2);
                    y = MFMA16(P.cf[s], bfr, y);
                }
                const int jb = dir ? 127 - (16 * sb + 15) : 16 * sb;
                *(f32x4*)(ybuf + (size_t)(row0 + tok_lo + jb + col) * 512 + g * 16 + 4 * gq) = y;
                LDS_WAIT(); asm volatile("" ::: "memory");
            }
        }
    }
}

constexpr int NPH = 3 + 9 * DEPTH;
__global__ void __launch_bounds__(512, 2) mega_fwd(Args args) {
    extern __shared__ __attribute__((aligned(16))) unsigned char lds_raw[];
    LAS unsigned char* lds = (LAS unsigned char*)lds_raw;
    volatile LAS unsigned* MISC = (volatile LAS unsigned*)(lds + MISC_OFF);
    const int tid0 = threadIdx.x;
    const int G = gridDim.x;
    for (int u = tid0; u < (LDS_BYTES - LDSCTL_OFF) / 4; u += 512) ((LAS unsigned*)(lds + LDSCTL_OFF))[u] = 0u;
    __syncthreads();
    XcdBarrier bar; bar.bar = (unsigned*)(args.ws + WS_CTL) + CW_BAR; bar.x = 0; bar.st = nullptr;
    const bool multi = (args.ph_hi - args.ph_lo) > 1;
    if (multi) bar = xcd_barrier_post((unsigned*)(args.ws + WS_CTL) + CW_BAR, MISC + 8);

#pragma unroll 1
    for (int ph = args.ph_lo; ph < args.ph_hi; ++ph) {
        const int layer = ph < 3 ? 0 : (ph - 3) / 9;
        const int kind = ph < 3 ? ph : 3 + (ph - 3) % 9;
        int tid = threadIdx.x; asm volatile("" : "+v"(tid));
        const int lane = tid & 63, wave = __builtin_amdgcn_readfirstlane(tid >> 6);
        int bx = blockIdx.x; asm volatile("" : "+s"(bx));
        const int vcu = (G % 8 == 0) ? (bx % 8) * (G / 8) + bx / 8 : bx;
        const int gw = vcu * 8 + wave, NGW = G * 8;
        size_t opq = 0; asm volatile("" : "+s"(opq));
        unsigned char* ws = args.ws + opq;
        float* modp = (float*)(ws + WS_MODP); float* modf = (float*)(ws + WS_MODF);
        bf16* kcb = (bf16*)(ws + WS_KC); bf16* cvt = (bf16*)(ws + WS_CVT);
        bf16* Hb = (bf16*)(ws + WS_H); bf16* QH = (bf16*)(ws + WS_QH); bf16* KH = (bf16*)(ws + WS_KH); bf16* VT = (bf16*)(ws + WS_VT);
        float* UB = (float*)(ws + WS_UB); float* PB = (float*)(ws + WS_PB); float* YF = (float*)(ws + WS_YF); float* YB = (float*)(ws + WS_YB);
        bf16* YA = (bf16*)(ws + WS_YA); bf16* CAT = (bf16*)(ws + WS_CAT); float* XA = (float*)(ws + WS_XA); bf16* HID = (bf16*)(ws + WS_HID);
        bf16* WIN = (bf16*)(ws + WS_WIN) + (size_t)layer * INW * D;
        bf16* WOUT = (bf16*)(ws + WS_WOUT) + (size_t)layer * D * D;
        bf16* WFI = (bf16*)(ws + WS_WFI) + (size_t)layer * 2 * FFH * D;
        bf16* WFO = (bf16*)(ws + WS_WFO) + (size_t)layer * D * FFH;
        bf16* WGLU = (bf16*)(ws + WS_WGLU) + (size_t)layer * 1024 * 512;
        const float* modl = modf + (size_t)layer * 3 * (6 * D);

        if (PHON(0) && kind == 0) {
            LAS float* scr = (LAS float*)(lds + wave * 16640);
            constexpr int N_MODP = 2 * 16 * 48;
            constexpr int T_IN = 32 * 56, T_OUT = 32 * 32, T_FI = 32 * 176, T_FO = 88 * 32, T_GLU = 8 * 16, T_L = T_IN + T_OUT + T_FI + T_FO + T_GLU;
            constexpr int N_FOLD = 2 * 4 * 256, N_CACHE = 4096;
            constexpr int NITEMS = N_MODP + 2 * T_L + N_FOLD + 2 * N_CACHE;
            for (int it = gw; it < NITEMS; it += NGW) {
                int r = it;
                if (r < N_MODP) { const int l = r / 768, q = r % 768; modp_item(args.in[I_WMOD], args.in[I_C], args.in[I_CCTX], modp, l, q / 48, q % 48, lane); continue; } r -= N_MODP;
                if (r < 2 * T_L) {
                    const int l = r / T_L; r %= T_L;
                    if (r < T_IN) { transpose_item(args.in[I_WIN] + (size_t)l * D * INW, INW, D, (bf16*)(ws + WS_WIN) + (size_t)l * INW * D, 0, 0, scr, r / 56, r % 56, lane); continue; } r -= T_IN;
                    if (r < T_OUT) { transpose_item(args.in[I_WOUT] + (size_t)l * D * D, D, D, (bf16*)(ws + WS_WOUT) + (size_t)l * D * D, 0, 0, scr, r / 32, r % 32, lane); continue; } r -= T_OUT;
                    if (r < T_FI) { transpose_item(args.in[I_WFI] + (size_t)l * D * 2 * FFH, 2 * FFH, D, (bf16*)(ws + WS_WFI) + (size_t)l * 2 * FFH * D, 1, FFH, scr, r / 176, r % 176, lane); continue; } r -= T_FI;
                    if (r < T_FO) { transpose_item(args.in[I_WFO] + (size_t)l * FFH * D, D, FFH, (bf16*)(ws + WS_WFO) + (size_t)l * D * FFH, 0, 0, scr, r / 32, r % 32, lane); continue; } r -= T_FO;
                    transpose_item(args.in[I_WGLU] + (size_t)l * 512 * 1024, 1024, 512, (bf16*)(ws + WS_WGLU) + (size_t)l * 1024 * 512, 1, 512, scr, r / 16, r % 16, lane); continue;
                }
                r -= 2 * T_L;
                if (r < N_FOLD) { const int l = r / 1024, q = r % 1024; fold_item(args.in[I_WIN] + (size_t)l * D * INW, args.in[I_POOLW] + (size_t)l * 4 * 128 * 128, args.in[I_POOLS] + (size_t)l * 512,
                                                                              (bf16*)(ws + WS_WIN) + (size_t)l * INW * D, q / 256, q % 256, lane); continue; }
                r -= N_FOLD;
                if (r < N_CACHE) {
                    const size_t e = (size_t)r * 512 + lane * 8;
                    const f32x4 a0 = *(const f32x4*)(args.in[I_CK] + e), a1 = *(const f32x4*)(args.in[I_CK] + e + 4);
                    v4u w; w.x = pk2(a0[0], a0[1]); w.y = pk2(a0[2], a0[3]); w.z = pk2(a1[0], a1[1]); w.w = pk2(a1[2], a1[3]);
                    *(v4u*)(kcb + e) = w; continue;
                }
                r -= N_CACHE;
                {
                    const int blh = r >> 6, rem = r & 63, dgrp = rem >> 3, tg = rem & 7;
                    const int t0 = tg * 64 + lane;
                    const float* src = args.in[I_CV] + ((size_t)blh * 512 + t0) * 64 + dgrp * 8;
                    const f32x4 a0 = *(const f32x4*)src, a1 = *(const f32x4*)(src + 4);
                    bf16* dst = cvt + ((size_t)blh * 64 + dgrp * 8) * 512 + t0;
                    dst[0] = (bf16)f2bf(a0[0]); dst[512] = (bf16)f2bf(a0[1]); dst[1024] = (bf16)f2bf(a0[2]); dst[1536] = (bf16)f2bf(a0[3]);
                    dst[2048] = (bf16)f2bf(a1[0]); dst[2560] = (bf16)f2bf(a1[1]); dst[3072] = (bf16)f2bf(a1[2]); dst[3584] = (bf16)f2bf(a1[3]);
                }
            }
        } else if (PHON(1) && kind == 1) {
            for (int e = bx * 512 + tid; e < 2 * 3 * 6 * D; e += G * 512) {
                const int l = e / (3 * 6 * D), rj = e % (3 * 6 * D), rr = rj / (6 * D), j = rj % (6 * D);
                float s = args.in[I_BMOD][(size_t)l * 6 * D + j];
#pragma unroll
                for (int kc = 0; kc < 16; ++kc) s += modp[((size_t)(l * 16 + kc) * 3 + rr) * (6 * D) + j];
                modf[e] = s;
            }
        } else if (PHON(2) && (kind == 2 || kind == 8 || kind == 11)) {
            const bool fin = (kind == 11 && layer == DEPTH - 1);
            const int nl = (kind == 11) ? layer + 1 : layer;
            const int which = (kind == 8) ? 3 : 0;
            for (int row = gw; row < MTOK; row += NGW) {
                const float* xr = (kind == 2) ? (row < NCTX ? args.in[I_XP] + (size_t)row * D : args.in[I_XS] + (size_t)(row - NCTX) * D) : XA + (size_t)row * D;
                if (fin) { norm_row(xr, args.in[I_FNG], nullptr, nullptr, nullptr, args.out + (size_t)row * D, lane); }
                else {
                    const float* mrow = modf + ((size_t)nl * 3 + cond_of_row(row)) * (6 * D);
                    const float* gain = (kind == 8 ? args.in[I_N2G] : args.in[I_N1G]) + (size_t)nl * D;
                    norm_row(xr, gain, mrow + which * D, mrow + (which + 1) * D, Hb + (size_t)row * D, nullptr, lane);
                }
            }
        } else if (PHON(3) && kind == 3) {
            pg8::Gemm g{Hb, WIN, MTOK, INW, D}; pg8::StaticOrder S; S.init(MTOK, INW, G, bx);
            EpiIn E{QH, KH, VT, UB, PB, args.out + OUT_CK, args.out + OUT_CV, layer};
            pg8::gemm_phase<EpiIn, pg8::StaticOrder, true, true>(lds, g, S, E, tid);
        } else if (PHON(4) && kind == 4) {
            constexpr int T_SL = 128, T_AL = 512, T_SC = 256, T_AC = 1024, T_PL = 384, T_ALL = T_SL + T_AL + T_SC + T_AC + T_PL;
            LAS float* ulds = (LAS float*)(lds + wave * 8192);
            LAS unsigned* hbuf = (LAS unsigned*)(lds + 65536 + wave * 4352);
            LAS float* Fl = (LAS float*)(lds + 65536 + 8 * 4352);
            for (int task = bx; task < T_ALL; task += G) {
                int r = task;
                int tl = lane; asm volatile("" : "+v"(tl));
                const int tidl = wave * 64 + tl;
                if (r < T_SL) {
                    const int b = r >> 6, g = (r >> 1) & 31, dir = r & 1, c = wave;
                    SsmPar P; ssm_params(P, args, layer, dir, g, tl);
                    const int row0 = NCTX + b * 2048 + 256 * c;
                    float hr = 0.f, hi = 0.f;
                    ssm_scan256<false>(P, UB, nullptr, row0, dir, g, hr, hi, ulds, hbuf, tl);
                    Fl[(c * 64 + tl) * 2] = hr; Fl[(c * 64 + tl) * 2 + 1] = hi;
                    __syncthreads();
                    float pr = P.are, pi = P.aim;
#pragma unroll
                    for (int q = 0; q < 8; ++q) { const float nr = pr * pr - pi * pi, ni = 2.f * pr * pi; pr = nr; pi = ni; }
                    const float* st = args.in[I_ST] + ((((size_t)(b * 2 + layer) * 2 + dir) * 32 + g) * 64 + tl) * 2;
                    hr = st[0]; hi = st[1];
                    if (dir == 0) { for (int cc = 0; cc < c; ++cc) { const float fr_ = Fl[(cc * 64 + tl) * 2], fi_ = Fl[(cc * 64 + tl) * 2 + 1]; const float nr = pr * hr - pi * hi + fr_, ni = pr * hi + pi * hr + fi_; hr = nr; hi = ni; } }
                    else { for (int cc = 7; cc > c; --cc) { const float fr_ = Fl[(cc * 64 + tl) * 2], fi_ = Fl[(cc * 64 + tl) * 2 + 1]; const float nr = pr * hr - pi * hi + fr_, ni = pr * hi + pi * hr + fi_; hr = nr; hi = ni; } }
                    ssm_scan256<true>(P, UB, dir ? YB : YF, row0, dir, g, hr, hi, ulds, hbuf, tl);
                    __syncthreads();
                    continue;
                }
                r -= T_SL;
                if (r < T_AL) {
                    const int b = r >> 8, h = (r >> 4) & 15, rp = r & 15;
                    attn_lat_wave(QH, KH, VT, kcb, cvt, args.in[I_RPB] + ((size_t)layer * 16 + h) * 15 * 31, CAT, layer, b, h, 2 * rp + (wave >> 2), wave & 3, tl);
                    continue;
                }
                r -= T_AL;
                if (r < T_SC) {
                    const int item = r * 8 + wave; const int b = item >> 6, g = (item >> 1) & 31, dir = item & 1;
                    SsmPar P; ssm_params(P, args, layer, dir, g, tl);
                    float hr = 0.f, hi = 0.f;
                    ssm_scan256<true>(P, UB, dir ? YB : YF, b * 256, dir, g, hr, hi, ulds, hbuf, tl);
                    float* so = args.out + OUT_ST + ((((size_t)(b * 2 + layer) * 2 + dir) * 32 + g) * 64 + tl) * 2;
                    *(f32x2*)so = (f32x2){hr, hi};
                    continue;
                }
                r -= T_SC;
                if (r < T_AC) {
                    const int b = r >> 5, h = (r >> 1) & 15, half = r & 1;
                    attn_ctx_wave(QH, KH, VT, CAT, b, h, half * 8 + wave, tl);
                    continue;
                }
                r -= T_AC;
                {
                    const int row0 = r * 32; const int ch = tidl; const int win = 2 << (ch >> 7);
                    const int seq0 = row0 < NCTX ? (row0 & ~255) : NCTX + ((row0 - NCTX) & ~2047);
                    const int n = row0 < NCTX ? 256 : 2048;
                    for (int i = 0; i < 32; ++i) {
                        const int t = row0 + i - seq0;
                        const int lo = max(t - win / 2, 0), hi2 = min(t - win / 2 + win, n);
                        float s = 0.f;
                        for (int q = lo; q < hi2; ++q) s += PB[(size_t)(seq0 + q) * 512 + ch];
                        const float v = s / (float)(hi2 - lo) - PB[(size_t)(row0 + i) * 512 + ch];
                        CAT[(size_t)(row0 + i) * D + 1536 + ch] = (bf16)f2bf(v);
                    }
                }
            }
        } else if (PHON(5) && kind == 5) {
            const float* dsk = args.in[I_SD] + (size_t)layer * 512;
            for (size_t e4 = (size_t)bx * 512 + tid; e4 < (size_t)MTOK * 128; e4 += (size_t)G * 512) {
                const int c4 = (int)(e4 & 127) * 4;
                const f32x4 u = *(const f32x4*)(UB + e4 * 4), yf = *(const f32x4*)(YF + e4 * 4), yb = *(const f32x4*)(YB + e4 * 4), dd = *(const f32x4*)(dsk + c4);
                float o[4];
#pragma unroll
                for (int i = 0; i < 4; ++i) { const float x = dd[i] * u[i] + yf[i] + yb[i]; const float z = 0.7978845608028654f * (x + 0.044715f * x * x * x); o[i] = x / (1.f + __expf(-2.f * z)); }
                v2u w; w.x = pk2(o[0], o[1]); w.y = pk2(o[2], o[3]);
                *(v2u*)(YA + e4 * 4) = w;
            }
        } else if (PHON(6) && kind == 6) {
            pg8::Gemm g{YA, WGLU, MTOK, 1024, 512}; pg8::StaticOrder S; S.init(MTOK, 1024, G, bx);
            EpiGlu E{CAT, args.in[I_BGLU] + (size_t)layer * 1024};
            pg8::gemm_phase<EpiGlu, pg8::StaticOrder, true, true>(lds, g, S, E, tid);
        } else if (PHON(7) && kind == 7) {
            pg8::Gemm g{CAT, WOUT, MTOK, D, D}; pg8::StaticOrder S; S.init(MTOK, D, G, bx);
            EpiRes E{layer == 0 ? args.in[I_XP] : XA, layer == 0 ? args.in[I_XS] : XA + (size_t)NCTX * D, XA, modl + 2 * D};
            pg8::gemm_phase<EpiRes, pg8::StaticOrder, true, true>(lds, g, S, E, tid);
        } else if (PHON(9) && kind == 9) {
            pg8::Gemm g{Hb, WFI, MTOK, 2 * FFH, D}; pg8::StaticOrder S; S.init(MTOK, 2 * FFH, G, bx);
            EpiSwi E{HID};
            pg8::gemm_phase<EpiSwi, pg8::StaticOrder, true, true>(lds, g, S, E, tid);
        } else if (PHON(10) && kind == 10) {
            pg8::Gemm g{HID, WFO, MTOK, D, FFH}; pg8::StaticOrder S; S.init(MTOK, D, G, bx);
            EpiRes E{XA, XA + (size_t)NCTX * D, XA, modl + 5 * D};
            pg8::gemm_phase<EpiRes, pg8::StaticOrder, true, true>(lds, g, S, E, tid);
        }
        if (ph + 1 < args.ph_hi) xcd_barrier(bar);
    }
}

extern "C" void kernel_launch(void* const* d_in, const int* in_sizes, int n_in, void* d_out, int out_size, void* d_ws, size_t ws_size, hipStream_t stream) {
    static int grid = 0;
    if (grid == 0) {
        if (n_in != 29 || ws_size < WS_END) { fprintf(stderr, "kernel_launch: need 29 inputs and >= %zu bytes of workspace; got %d, %zu\n", (size_t)WS_END, n_in, ws_size); grid = -1; return; }
        int dev = 0, cus = 0;
        if (hipGetDevice(&dev) != hipSuccess || hipDeviceGetAttribute(&cus, hipDeviceAttributeMultiprocessorCount, dev) != hipSuccess) { grid = -1; return; }
        if (hipFuncSetAttribute((const void*)mega_fwd, hipFuncAttributeMaxDynamicSharedMemorySize, LDS_BYTES) != hipSuccess) { fprintf(stderr, "kernel_launch: hipFuncSetAttribute failed\n"); grid = -1; return; }
        (void)hipGetLastError();
        grid = cus;
    }
    if (grid < 0) return;
    (void)hipMemsetAsync((char*)d_ws + WS_CTL, 0, CTL_ZERO_BYTES, stream);
    Args a{};
    for (int i = 0; i < 29; ++i) a.in[i] = (const float*)d_in[i];
    a.out = (float*)d_out; a.ws = (unsigned char*)d_ws;
#if MK_N_LAUNCHES == 1
    a.ph_lo = 0; a.ph_hi = NPH;
    hipLaunchKernelGGL(mega_fwd, dim3(grid), dim3(512), LDS_BYTES, stream, a);
#else
    for (int p = 0; p < NPH; ++p) { a.ph_lo = p; a.ph_hi = p + 1; hipLaunchKernelGGL(mega_fwd, dim3(grid), dim3(512), LDS_BYTES, stream, a); }
#endif
}
```

```cpp
#include <hip/hip_runtime.h>
#include <cstdio>
#include <cstdint>

#ifndef PHMASK
#define PHMASK 0xFFFF
#endif
#define PHON(k) (((PHMASK) >> (k)) & 1)
#ifndef REPMASK
#define REPMASK 0
#endif
#ifndef MIXMASK
#define MIXMASK 31
#endif
#ifndef REPLAYER
#define REPLAYER -1
#endif
#ifndef MK_N_LAUNCHES
#define MK_N_LAUNCHES 1
#endif

namespace pg8 {
#define PG8_LAS __attribute__((address_space(3)))
typedef unsigned short bf16_t;
typedef short bf16x8 __attribute__((ext_vector_type(8)));
typedef float f32x4 __attribute__((ext_vector_type(4)));
typedef unsigned u32x4 __attribute__((ext_vector_type(4)));
constexpr int BM = 256, BK = 64, HALF = 128, HTB = HALF * BK * 2, STAGE_BYTES = 8 * HTB, NXCD = 8, WGM = 8;

__host__ __device__ __forceinline__ int lds_byte(int r, int c) { const int st = (r >> 4) * 2 + (c >> 5), rr = r & 15, cc = c & 31, ob = rr * 64 + cc * 2; return st * 1024 + (ob ^ (((ob >> 9) & 1) << 5)); }
__host__ __device__ __forceinline__ void stage_rc(int b, int& R, int& C) { const int st = b / 1024, sb = b % 1024, swz = sb ^ (((sb >> 9) & 1) << 5); R = (st >> 1) * 16 + swz / 64; C = (st & 1) * 32 + (swz % 64) / 2; }

struct Unit { int pm, pn; };
struct Gemm { const bf16_t* A; const bf16_t* Bt; int M, N, K; };

struct StaticOrder {
    int nM, nN, nwg, G, c;
    __host__ __device__ void init(int M, int N, int G_, int c_) { nM = M / BM; nN = N / BM; nwg = nM * nN; G = G_; c = c_; }
    __host__ __device__ bool next(int i, Unit& u) const {
        const long L = (long)i * G + c; if (L >= nwg) return false;
        int wgid = (int)L; { const int q = nwg / NXCD, r = nwg % NXCD, xcd = wgid % NXCD, off = wgid / NXCD; wgid = (xcd < r ? xcd * (q + 1) : r * (q + 1) + (xcd - r) * q) + off; }
        const int nig = WGM * nN, gid = wgid / nig, fm = gid * WGM, gsz = (nM - fm) < WGM ? (nM - fm) : WGM;
        u.pm = fm + ((wgid % nig) % gsz); u.pn = (wgid % nig) / gsz; return true;
    }
    __device__ __forceinline__ void a_ready(const Unit&) const {}
    __device__ __forceinline__ void done(const Unit&) const {}
};

__device__ __forceinline__ unsigned cvt_pk_bf16(float lo, float hi) { unsigned r; asm volatile("v_cvt_pk_bf16_f32 %0, %1, %2" : "=v"(r) : "v"(lo), "v"(hi)); return r; }

template <class Epi, class Sched, bool ALIGN_EPI = false, bool SP2 = false>
__device__ __forceinline__ void gemm_phase(PG8_LAS unsigned char* lds, const Gemm g, const Sched& S, const Epi& E, const int tid) {
    const int wid = __builtin_amdgcn_readfirstlane(tid >> 6), lane = tid & 63, wr = wid >> 2, wc = wid & 3, fr = lane & 15, fq = lane >> 4;
    const int K = g.K, nt = K / BK;
    unsigned voffA[2], voffB[2];
#pragma unroll
    for (int i = 0; i < 2; ++i) { int R, C; stage_rc(tid * 16 + i * 8192, R, C);
        voffA[i] = (unsigned)(R * K + C) * 2u; voffB[i] = (unsigned)(R * K + C) * 2u; }
    const size_t kstep = (size_t)(BK * 2);
    const size_t hstep = (size_t)HALF * K * 2;
    const size_t tstep = 2 * hstep;
    const unsigned ldsw = (unsigned)wid * 1024u;
    const int aoff = lds_byte(wr * 64 + fr, fq * 8), boff = lds_byte(wc * 32 + fr, fq * 8);
#define PG8_SA(b, h) (((b) * 2 + (h)) * HTB)
#define PG8_SB(b, h) ((4 + (b) * 2 + (h)) * HTB)
#define PG8_STAGE(bufoff, gbase, voff) do { _Pragma("unroll") for (int _i = 0; _i < 2; ++_i) \
        __builtin_amdgcn_global_load_lds((const unsigned*)((const char*)(gbase) + (voff)[_i]), (PG8_LAS unsigned*)(lds + (bufoff) + ldsw + _i * 8192), 16, 0, 0); } while (0)
#define PG8_LDA(dst, b, h) do { _Pragma("unroll") for (int m = 0; m < 4; ++m) _Pragma("unroll") for (int k = 0; k < 2; ++k) dst[m][k] = *(const PG8_LAS bf16x8*)(lds + PG8_SA(b, h) + aoff + m * 2048 + k * 1024); } while (0)
#define PG8_LDB(dst, b, h) do { _Pragma("unroll") for (int n = 0; n < 2; ++n) _Pragma("unroll") for (int k = 0; k < 2; ++k) dst[n][k] = *(const PG8_LAS bf16x8*)(lds + PG8_SB(b, h) + boff + n * 2048 + k * 1024); } while (0)
#define PG8_MMA(ai, bj, At, Bt) do { __builtin_amdgcn_s_setprio(1); _Pragma("unroll") for (int m = 0; m < 4; ++m) _Pragma("unroll") for (int n = 0; n < 2; ++n) _Pragma("unroll") for (int k = 0; k < 2; ++k) \
        acc[ai][bj][m][n] = __builtin_amdgcn_mfma_f32_16x16x32_bf16(Bt[n][k], At[m][k], acc[ai][bj][m][n], 0, 0, 0); __builtin_amdgcn_s_setprio(0); } while (0)
#define PG8_WAIT_V(n) asm volatile("s_waitcnt vmcnt(" #n ")" ::: "memory")
#define PG8_WAIT_L(n) asm volatile("s_waitcnt lgkmcnt(" #n ")" ::: "memory")
#define PG8_BAR __builtin_amdgcn_s_barrier()
#define PG8_SCHED __builtin_amdgcn_sched_barrier(0)
    Unit cur, nxt; int ui = 0;
    if (!S.next(0, cur)) return;
    f32x4 acc[2][2][4][2];
#pragma unroll
    for (int a = 0; a < 2; ++a)
#pragma unroll
        for (int b = 0; b < 2; ++b)
#pragma unroll
            for (int m = 0; m < 4; ++m)
#pragma unroll
                for (int n = 0; n < 2; ++n) acc[a][b][m][n] = (f32x4){0.f, 0.f, 0.f, 0.f};
    bf16x8 At[4][2], B0[2][2], B1[2][2];
    const char* cA = (const char*)g.A + (size_t)cur.pm * tstep; const char* cB = (const char*)g.Bt + (size_t)cur.pn * tstep;
    S.a_ready(cur);
    if constexpr (SP2) {
        PG8_STAGE(PG8_SB(0, 0), cB, voffB); PG8_STAGE(PG8_SB(0, 1), cB + hstep, voffB); PG8_STAGE(PG8_SA(0, 0), cA, voffA); PG8_STAGE(PG8_SA(0, 1), cA + hstep, voffA);
        if (wr == 1) PG8_BAR;
        PG8_WAIT_V(2); PG8_BAR;
        PG8_STAGE(PG8_SB(1, 0), cB + kstep, voffB); PG8_STAGE(PG8_SA(1, 0), cA + kstep, voffA); PG8_STAGE(PG8_SB(1, 1), cB + hstep + kstep, voffB);
        PG8_WAIT_V(6); PG8_BAR;
    } else {
        PG8_STAGE(PG8_SB(0, 0), cB, voffB); PG8_STAGE(PG8_SA(0, 0), cA, voffA); PG8_STAGE(PG8_SB(0, 1), cB + hstep, voffB); PG8_STAGE(PG8_SA(0, 1), cA + hstep, voffA);
        if (wr == 1) PG8_BAR;
        PG8_WAIT_V(4); PG8_BAR;
        PG8_STAGE(PG8_SB(1, 0), cB + kstep, voffB); PG8_STAGE(PG8_SA(1, 0), cA + kstep, voffA); PG8_STAGE(PG8_SB(1, 1), cB + hstep + kstep, voffB);
        PG8_WAIT_V(6); PG8_BAR;
    }
    for (;;) {
        const bool has_next = S.next(ui + 1, nxt);
        const char* nA = has_next ? (const char*)g.A + (size_t)nxt.pm * tstep : cA; const char* nB = has_next ? (const char*)g.Bt + (size_t)nxt.pn * tstep : cB;
        for (int t = 0; t < nt; t += 2) {
            const bool last = (t == nt - 2);
            const char* a1 = cA + (size_t)(t + 1) * kstep;
            const char* a2 = last ? nA : cA + (size_t)(t + 2) * kstep; const char* b2 = last ? nB : cB + (size_t)(t + 2) * kstep;
            const char* a3 = a2 + kstep; const char* b3 = b2 + kstep;
            if (last && has_next) S.a_ready(nxt);
            if constexpr (SP2) {
            PG8_LDB(B0, 0, 0); PG8_LDB(B1, 0, 1); PG8_SCHED; PG8_LDA(At, 0, 0); PG8_STAGE(PG8_SA(1, 1), a1 + hstep, voffA);
            PG8_WAIT_V(8); PG8_WAIT_L(0); PG8_BAR; PG8_MMA(0, 0, At, B0); PG8_MMA(0, 1, At, B1); PG8_BAR; PG8_SCHED;
            PG8_LDA(At, 0, 1); PG8_STAGE(PG8_SB(0, 0), b2, voffB); PG8_STAGE(PG8_SB(0, 1), b2 + hstep, voffB); PG8_STAGE(PG8_SA(0, 0), a2, voffA);
            PG8_WAIT_V(8); PG8_WAIT_L(0); PG8_BAR; PG8_MMA(1, 0, At, B0); PG8_MMA(1, 1, At, B1); PG8_BAR; PG8_SCHED;
            PG8_LDB(B0, 1, 0); PG8_LDB(B1, 1, 1); PG8_SCHED; PG8_LDA(At, 1, 0); PG8_STAGE(PG8_SA(0, 1), a2 + hstep, voffA);
            PG8_WAIT_V(8); PG8_WAIT_L(0); PG8_BAR; PG8_MMA(0, 0, At, B0); PG8_MMA(0, 1, At, B1); PG8_BAR; PG8_SCHED;
            PG8_LDA(At, 1, 1); PG8_STAGE(PG8_SB(1, 0), b3, voffB); PG8_STAGE(PG8_SB(1, 1), b3 + hstep, voffB); PG8_STAGE(PG8_SA(1, 0), a3, voffA);
            PG8_WAIT_V(8); PG8_WAIT_L(0); PG8_BAR; PG8_MMA(1, 0, At, B0); PG8_MMA(1, 1, At, B1); PG8_BAR; PG8_SCHED;
            } else {
            PG8_LDB(B0, 0, 0); PG8_SCHED; PG8_LDA(At, 0, 0); PG8_STAGE(PG8_SA(1, 1), a1 + hstep, voffA);
            PG8_WAIT_L(8); PG8_BAR; PG8_WAIT_L(0); PG8_MMA(0, 0, At, B0); PG8_BAR; PG8_SCHED;
            PG8_LDB(B1, 0, 1); PG8_STAGE(PG8_SB(0, 0), b2, voffB);
            PG8_BAR; PG8_WAIT_L(0); PG8_MMA(0, 1, At, B1); PG8_BAR;
            PG8_LDA(At, 0, 1); PG8_STAGE(PG8_SA(0, 0), a2, voffA);
            PG8_BAR; PG8_WAIT_L(0); PG8_MMA(1, 0, At, B0); PG8_BAR; PG8_SCHED;
            PG8_STAGE(PG8_SB(0, 1), b2 + hstep, voffB);
            PG8_WAIT_V(6); PG8_BAR; PG8_MMA(1, 1, At, B1); PG8_BAR;
            PG8_LDB(B0, 1, 0); PG8_SCHED; PG8_LDA(At, 1, 0); PG8_STAGE(PG8_SA(0, 1), a2 + hstep, voffA);
            PG8_WAIT_L(8); PG8_BAR; PG8_WAIT_L(0); PG8_MMA(0, 0, At, B0); PG8_BAR; PG8_SCHED;
            PG8_LDB(B1, 1, 1); PG8_STAGE(PG8_SB(1, 0), b3, voffB);
            PG8_BAR; PG8_WAIT_L(0); PG8_MMA(0, 1, At, B1); PG8_BAR;
            PG8_LDA(At, 1, 1); PG8_STAGE(PG8_SA(1, 0), a3, voffA);
            PG8_BAR; PG8_WAIT_L(0); PG8_MMA(1, 0, At, B0); PG8_BAR; PG8_SCHED;
            PG8_STAGE(PG8_SB(1, 1), b3 + hstep, voffB);
            PG8_WAIT_V(6); PG8_BAR; PG8_MMA(1, 1, At, B1); PG8_BAR;
            }
        }
        if constexpr (ALIGN_EPI) { if (wr == 0) PG8_BAR; }
        E(acc, cur, wr, wc, fr, fq); S.done(cur);
        if (!has_next) break;
#pragma unroll
        for (int a = 0; a < 2; ++a)
#pragma unroll
            for (int b = 0; b < 2; ++b)
#pragma unroll
                for (int m = 0; m < 4; ++m)
#pragma unroll
                    for (int n = 0; n < 2; ++n) acc[a][b][m][n] = (f32x4){0.f, 0.f, 0.f, 0.f};
        cur = nxt; cA = nA; cB = nB; ++ui;
        if constexpr (ALIGN_EPI) { if (wr == 1) PG8_BAR; }
    }
    PG8_WAIT_V(0);
    if constexpr (!ALIGN_EPI) { if (wr == 0) PG8_BAR; }
    PG8_BAR;
#undef PG8_SA
#undef PG8_SB
#undef PG8_STAGE
#undef PG8_LDA
#undef PG8_LDB
#undef PG8_MMA
#undef PG8_WAIT_V
#undef PG8_WAIT_L
#undef PG8_BAR
#undef PG8_SCHED
}
}

constexpr int D = 2048, NCTX = 8192, NLAT = 4096, MTOK = NCTX + NLAT;
constexpr int DEPTH = 2, NH = 16, HD = 64, ATTW = 1024, SSMW = 512, POOLW = 512, INW = 4096, FFH = 5632;
constexpr int SEQ = 256, DSEQ = 2048, PAST = 512, GW = 64;
constexpr float RMS_EPS = 1e-6f;
constexpr float LOG2E = 1.4426950408889634f;
constexpr float QSCALE = 0.125f * LOG2E;

constexpr size_t OUT_YP = 0, OUT_YS = (size_t)NCTX * D, OUT_CK = OUT_YS + (size_t)NLAT * D, OUT_CV = OUT_CK + (size_t)32 * 2 * 16 * 256 * 64, OUT_ST = OUT_CV + (size_t)32 * 2 * 16 * 256 * 64;

constexpr size_t MiB = 1u << 20;
constexpr size_t WS_CTL = 0, CTL_ZERO_BYTES = 1 * MiB;
constexpr size_t WS_MODP = 1 * MiB;
constexpr size_t WS_MODF = 6 * MiB;
constexpr size_t WS_KC = 8 * MiB;
constexpr size_t WS_CVT = 12 * MiB;
constexpr size_t WS_WIN = 16 * MiB;
constexpr size_t WS_WOUT = 48 * MiB;
constexpr size_t WS_WFI = 64 * MiB;
constexpr size_t WS_WFO = 152 * MiB;
constexpr size_t WS_WGLU = 196 * MiB;
constexpr size_t WS_H = 200 * MiB;
constexpr size_t WS_QH = 248 * MiB, WS_KH = 272 * MiB, WS_VT = 296 * MiB;
constexpr size_t WS_UB = 320 * MiB, WS_PB = 344 * MiB, WS_YF = 368 * MiB, WS_YB = 392 * MiB;
constexpr size_t WS_YA = 416 * MiB;
constexpr size_t WS_CAT = 428 * MiB;
constexpr size_t WS_XA = 476 * MiB;
constexpr size_t WS_HID = 572 * MiB;
constexpr size_t WS_END = 704 * MiB;
constexpr int CW_BAR = 4096, CW_TASK = 512;

constexpr int RING_BYTES = 131072;
constexpr int LDSCTL_OFF = 139264, MISC_OFF = LDSCTL_OFF + 320;
constexpr int LDS_BYTES = 147456;

#define GAS __attribute__((address_space(1)))
#define LAS __attribute__((address_space(3)))
typedef unsigned short bf16;
typedef unsigned v4u __attribute__((ext_vector_type(4)));
typedef unsigned v2u __attribute__((ext_vector_type(2)));
typedef float f32x4 __attribute__((ext_vector_type(4)));
typedef float f32x2 __attribute__((ext_vector_type(2)));
typedef short bf16x8 __attribute__((ext_vector_type(8)));
#define LDS_WAIT() asm volatile("s_waitcnt lgkmcnt(0)" ::: "memory")
#define VM_WAIT() asm volatile("s_waitcnt vmcnt(0)" ::: "memory")
__device__ __forceinline__ unsigned f2bf(float f) { unsigned u = __builtin_bit_cast(unsigned, f); return (u + 0x7fffu + ((u >> 16) & 1u)) >> 16; }
__device__ __forceinline__ unsigned pk2(float lo, float hi) { return pg8::cvt_pk_bf16(lo, hi); }

#define XB_TMO      128
#define XB_XCNT(j)  (256  + 64 * (j))
#define XB_XSUB(j)  (1280 + 64 * (j))
#define XB_XGEN(j)  (2304 + 64 * (j))
#define XB_TOP      3328
#define XB_TOPGEN   3392
#define XCD_BAR_WORDS 3456
#define XB_SPIN_CAP (1u << 18)
__device__ __forceinline__ unsigned xb_ld(unsigned* p)              { return __hip_atomic_load(p, __ATOMIC_RELAXED, __HIP_MEMORY_SCOPE_AGENT); }
__device__ __forceinline__ unsigned xb_add(unsigned* p, unsigned v) { return __hip_atomic_fetch_add(p, v, __ATOMIC_RELAXED, __HIP_MEMORY_SCOPE_AGENT); }
__device__ __forceinline__ unsigned xb_xcc_id() { return (unsigned)__builtin_amdgcn_s_getreg((3 << 11) | 20) & 0xFu; }
#define XB_SPIN(cond, bar) do { unsigned _sp = 0; while (cond) { __builtin_amdgcn_s_sleep(1); \
    if ((++_sp & 255u) == 0u) { if (xb_ld(&(bar)[XB_TMO])) break; if (_sp > XB_SPIN_CAP) { atomicAdd(&(bar)[XB_TMO], 1u); break; } } } } while (0)
struct XcdBarrier { unsigned* bar; unsigned x; volatile LAS unsigned* st; };
__device__ __forceinline__ XcdBarrier xcd_barrier_post(unsigned* bar, volatile LAS unsigned* st) {
    XcdBarrier b; b.bar = bar; b.x = xb_xcc_id(); b.st = st;
    if (threadIdx.x == 0) (void)xb_add(&bar[XB_XCNT(b.x)], 1u);
    return b;
}
__device__ __forceinline__ void xcd_barrier_complete(unsigned* bar, unsigned x, unsigned& nloc, unsigned& nx) {
    const unsigned G = gridDim.x * gridDim.y * gridDim.z;
    unsigned sum, cnt, mine, sp = 0u;
    for (;;) {
        sum = 0u; cnt = 0u; mine = 0u;
#pragma unroll
        for (unsigned j = 0; j < 16; ++j) { const unsigned c = xb_ld(&bar[XB_XCNT(j)]); sum += c; cnt += (c > 0u) ? 1u : 0u; mine = (j == x) ? c : mine; }
        if (sum == G) break;
        __builtin_amdgcn_s_sleep(1);
        if ((++sp & 255u) == 0u) { if (xb_ld(&bar[XB_TMO])) break; if (sp > XB_SPIN_CAP) { atomicAdd(&bar[XB_TMO], 1u); break; } }
    }
    nloc = mine > 0u ? mine : 1u; nx = cnt > 0u ? cnt : 1u;
}
__device__ __forceinline__ void xcd_barrier(const XcdBarrier& b) {
    asm volatile("s_waitcnt vmcnt(0)" ::: "memory");
    __syncthreads();
    if (threadIdx.x == 0) {
        unsigned* bar = b.bar;
        __builtin_amdgcn_s_waitcnt(0);
        unsigned nloc = b.st[0], nx = b.st[1];
        if (nloc == 0u) { xcd_barrier_complete(bar, b.x, nloc, nx); b.st[0] = nloc; b.st[1] = nx; }
        const unsigned old = xb_add(&bar[XB_XSUB(b.x)], 1u);
        const unsigned gen = old / nloc;
        if (old + 1u == (gen + 1u) * nloc) {
            __builtin_amdgcn_fence(__ATOMIC_RELEASE, "agent");
            asm volatile("s_waitcnt vmcnt(0)" ::: "memory");
            const unsigned og = xb_add(&bar[XB_TOP], 1u);
            const unsigned tg = og / nx;
            if (og + 1u == (tg + 1u) * nx) xb_add(&bar[XB_TOPGEN], 1u);
            else XB_SPIN(xb_ld(&bar[XB_TOPGEN]) == tg, bar);
            __builtin_amdgcn_fence(__ATOMIC_ACQUIRE, "agent");
            xb_add(&bar[XB_XGEN(b.x)], 1u);
            asm volatile("s_waitcnt vmcnt(0)" ::: "memory");
        } else {
            XB_SPIN(xb_ld(&bar[XB_XGEN(b.x)]) == gen, bar);
            __builtin_amdgcn_fence(__ATOMIC_ACQUIRE, "agent");
            asm volatile("s_waitcnt vmcnt(0)" ::: "memory");
        }
    }
    __syncthreads();
}

struct Args { const float* in[29]; float* out; unsigned char* ws; int ph_lo, ph_hi; };
enum { I_XP = 0, I_XS, I_C, I_CK, I_CV, I_ST, I_CCTX, I_WMOD, I_BMOD, I_N1G, I_N2G, I_WIN, I_RPB, I_ARE, I_AIM, I_LDT, I_BRE, I_BIM, I_CRE, I_CIM, I_SD, I_WGLU, I_BGLU,
       I_POOLW, I_POOLS, I_WOUT, I_WFI, I_WFO, I_FNG };

__device__ __forceinline__ float wave_sum(float v) {
#pragma unroll
    for (int o = 1; o < 64; o <<= 1) v += __shfl_xor(v, o);
    return v;
}
__device__ __forceinline__ int invperm32(int s) { return 16 * ((s >> 2) & 1) + 4 * (s >> 3) + (s & 3); }
__device__ __forceinline__ int bt_row(int s, int kind, int HS) {
    int d = s;
    if (kind == 1) { const int half = s >= HS ? 1 : 0; const int j = s - half * HS; d = (j >> 7) * 256 + half * 128 + (j & 127); }
    return (d & ~31) + invperm32(d & 31);
}
__device__ __forceinline__ size_t hrow(int row, int h) {
    if (row < NCTX) return ((size_t)((row >> 8) * 16 + h) << 8) + (size_t)(row & 255);
    const int r = row - NCTX; return (size_t)NCTX * 16 + ((size_t)((r >> 11) * 16 + h) << 11) + (size_t)(r & 2047);
}
__device__ __forceinline__ size_t vtidx(int row, int h, int d) {
    if (row < NCTX) return (((size_t)((row >> 8) * 16 + h) * 64 + d) << 8) + (size_t)(row & 255);
    const int r = row - NCTX; return (size_t)NCTX * 1024 + (((size_t)((r >> 11) * 16 + h) * 64 + d) << 11) + (size_t)(r & 2047);
}
__device__ __forceinline__ int cond_of_row(int row) { return row < NCTX ? 0 : 1 + ((row - NCTX) >> 11); }

__device__ __forceinline__ void transpose_item(const float* W, int ldw, int K, bf16* WT, int kind, int HS, LAS float* scr, int kb, int nb, int lane) {
    const int k0 = 64 * kb, n0 = 64 * nb;
    f32x4 v[16];
#pragma unroll
    for (int i = 0; i < 16; ++i) { const int kk = 4 * i + (lane >> 4); v[i] = *(const f32x4*)(W + (size_t)(k0 + kk) * ldw + n0 + 4 * (lane & 15)); }
#pragma unroll
    for (int i = 0; i < 16; ++i) { const int kk = 4 * i + (lane >> 4); LAS float* s = scr + kk * 65 + 4 * (lane & 15); s[0] = v[i][0]; s[1] = v[i][1]; s[2] = v[i][2]; s[3] = v[i][3]; }
    LDS_WAIT(); asm volatile("" ::: "memory");
    const int c = lane & 7;
#pragma unroll
    for (int j = 0; j < 8; ++j) { const int n = (lane >> 3) + 8 * j; const LAS float* s = scr + (8 * c) * 65 + n;
        v4u o; o.x = pk2(s[0 * 65], s[1 * 65]); o.y = pk2(s[2 * 65], s[3 * 65]); o.z = pk2(s[4 * 65], s[5 * 65]); o.w = pk2(s[6 * 65], s[7 * 65]);
        const int dr = bt_row(n0 + n, kind, HS);
        *(v4u*)(WT + (size_t)dr * K + k0 + 8 * c) = o; }
    LDS_WAIT(); asm volatile("" ::: "memory");
}
__device__ __forceinline__ void fold_item(const float* win_l, const float* pw_l, const float* ps_l, bf16* WT, int g, int kb, int lane) {
    const int k0 = 8 * kb;
    float a0[8], a1[8];
#pragma unroll
    for (int k = 0; k < 8; ++k) { a0[k] = 0.f; a1[k] = 0.f; }
    const float* wg = pw_l + (size_t)g * 128 * 128;
    for (int c = 0; c < 128; ++c) {
        const float b0 = wg[c * 128 + lane], b1 = wg[c * 128 + 64 + lane];
#pragma unroll
        for (int k = 0; k < 8; ++k) { const float a = win_l[(size_t)(k0 + k) * INW + 3584 + 128 * g + c]; a0[k] += a * b0; a1[k] += a * b1; }
    }
    const float s0 = ps_l[128 * g + lane], s1 = ps_l[128 * g + 64 + lane];
    v4u o0, o1;
    o0.x = pk2(a0[0] * s0, a0[1] * s0); o0.y = pk2(a0[2] * s0, a0[3] * s0); o0.z = pk2(a0[4] * s0, a0[5] * s0); o0.w = pk2(a0[6] * s0, a0[7] * s0);
    o1.x = pk2(a1[0] * s1, a1[1] * s1); o1.y = pk2(a1[2] * s1, a1[3] * s1); o1.z = pk2(a1[4] * s1, a1[5] * s1); o1.w = pk2(a1[6] * s1, a1[7] * s1);
    *(v4u*)(WT + (size_t)bt_row(3584 + 128 * g + lane, 0, 0) * D + k0) = o0;
    *(v4u*)(WT + (size_t)bt_row(3584 + 128 * g + 64 + lane, 0, 0) * D + k0) = o1;
}
__device__ __forceinline__ void modp_item(const float* wmod, const float* cvec, const float* cctx, float* modp, int l, int kc, int wcol, int lane) {
    const int col4 = wcol * 64 + lane;
    f32x4 a0 = {0.f, 0.f, 0.f, 0.f}, a1 = a0, a2 = a0;
    const float* wp = wmod + ((size_t)l * D + (size_t)kc * 128) * (6 * D) + 4 * col4;
#pragma unroll 8
    for (int k = 0; k < 128; ++k) {
        const int kk = kc * 128 + k;
        const f32x4 w = *(const f32x4*)(wp + (size_t)k * (6 * D));
        const float c0 = cctx[kk], c1 = cvec[kk], c2 = cvec[D + kk];
        const float s0 = c0 / (1.f + __expf(-c0)), s1 = c1 / (1.f + __expf(-c1)), s2 = c2 / (1.f + __expf(-c2));
        a0 += w * s0; a1 += w * s1; a2 += w * s2;
    }
    float* o = modp + ((size_t)(l * 16 + kc) * 3) * (6 * D) + 4 * col4;
    *(f32x4*)(o) = a0; *(f32x4*)(o + 6 * D) = a1; *(f32x4*)(o + 12 * D) = a2;
}

__device__ __forceinline__ void norm_row(const float* xrow, const float* gain, const float* shv, const float* scv, bf16* obf, float* of32, int lane) {
    f32x4 v[8]; float s = 0.f;
#pragma unroll
    for (int j = 0; j < 8; ++j) { v[j] = *(const f32x4*)(xrow + 4 * (64 * j + lane)); s += (v[j][0] * v[j][0] + v[j][1] * v[j][1]) + (v[j][2] * v[j][2] + v[j][3] * v[j][3]); }
    const float rstd = 1.0f / sqrtf(wave_sum(s) * (1.f / D) + RMS_EPS);
#pragma unroll
    for (int j = 0; j < 8; ++j) {
        const int c = 4 * (64 * j + lane);
        const f32x4 g = *(const f32x4*)(gain + c);
        f32x4 y = v[j] * rstd * g;
        if (obf) {
            const f32x4 sc = *(const f32x4*)(scv + c), sh = *(const f32x4*)(shv + c);
            y = y * (sc + 1.0f) + sh;
            v2u o; o.x = pk2(y[0], y[1]); o.y = pk2(y[2], y[3]);
            *(v2u*)(obf + c) = o;
        } else {
            *(f32x4*)(of32 + c) = y;
        }
    }
}

using pg8::Unit;
struct EpiIn {
    bf16 *qh, *kh, *vt; float *ub, *pb, *outk, *outv; int layer;
    static constexpr bool PERM = false, AFTER_DRAIN = false;
    __device__ __forceinline__ void operator()(const f32x4 (&acc)[2][2][4][2], const Unit& u, int wr, int wc, int fr, int fq) const {
        const int pn = u.pn, seg = pn >> 2;
#pragma unroll
        for (int ai = 0; ai < 2; ++ai)
#pragma unroll
            for (int m = 0; m < 4; ++m) {
                const int row = u.pm * 256 + ai * 128 + wr * 64 + m * 16 + fr;
#pragma unroll
                for (int bj = 0; bj < 2; ++bj) {
                    const f32x4 v0 = acc[ai][bj][m][0], v1 = acc[ai][bj][m][1];
                    const int cl = (pn & 3) * 256 + bj * 128 + wc * 32 + 8 * fq;
                    if (seg == 0) {
                        const int h = cl >> 6, d = cl & 63;
                        v4u w; w.x = pk2(v0[0] * QSCALE, v0[1] * QSCALE); w.y = pk2(v0[2] * QSCALE, v0[3] * QSCALE); w.z = pk2(v1[0] * QSCALE, v1[1] * QSCALE); w.w = pk2(v1[2] * QSCALE, v1[3] * QSCALE);
                        *(v4u*)(qh + hrow(row, h) * 64 + d) = w;
                    } else if (seg == 1) {
                        const int h = cl >> 6, d = cl & 63;
                        v4u w; w.x = pk2(v0[0], v0[1]); w.y = pk2(v0[2], v0[3]); w.z = pk2(v1[0], v1[1]); w.w = pk2(v1[2], v1[3]);
                        *(v4u*)(kh + hrow(row, h) * 64 + d) = w;
                        if (row < NCTX) { float* o = outk + ((((size_t)(row >> 8) * 2 + layer) * 16 + h) * 256 + (row & 255)) * 64 + d; *(f32x4*)o = v0; *(f32x4*)(o + 4) = v1; }
                    } else if (seg == 2) {
                        const int h = cl >> 6, d = cl & 63;
                        const size_t b0 = vtidx(row, h, d); const size_t st = row < NCTX ? 256 : 2048;
                        vt[b0] = (bf16)f2bf(v0[0]); vt[b0 + st] = (bf16)f2bf(v0[1]); vt[b0 + 2 * st] = (bf16)f2bf(v0[2]); vt[b0 + 3 * st] = (bf16)f2bf(v0[3]);
                        vt[b0 + 4 * st] = (bf16)f2bf(v1[0]); vt[b0 + 5 * st] = (bf16)f2bf(v1[1]); vt[b0 + 6 * st] = (bf16)f2bf(v1[2]); vt[b0 + 7 * st] = (bf16)f2bf(v1[3]);
                        if (row < NCTX) { float* o = outv + ((((size_t)(row >> 8) * 2 + layer) * 16 + h) * 256 + (row & 255)) * 64 + d; *(f32x4*)o = v0; *(f32x4*)(o + 4) = v1; }
                    } else {
                        float* o = (cl < 512 ? ub + (size_t)row * 512 + cl : pb + (size_t)row * 512 + (cl - 512));
                        *(f32x4*)o = v0; *(f32x4*)(o + 4) = v1;
                    }
                }
            }
    }
};
struct EpiGlu {
    bf16* cat; const float* bias;
    static constexpr bool PERM = false, AFTER_DRAIN = false;
    __device__ __forceinline__ void operator()(const f32x4 (&acc)[2][2][4][2], const Unit& u, int wr, int wc, int fr, int fq) const {
        const int j0 = u.pn * 128 + wc * 32 + 8 * fq;
        const f32x4 bv0 = *(const f32x4*)(bias + j0), bv1 = *(const f32x4*)(bias + j0 + 4), bg0 = *(const f32x4*)(bias + 512 + j0), bg1 = *(const f32x4*)(bias + 512 + j0 + 4);
#pragma unroll
        for (int ai = 0; ai < 2; ++ai)
#pragma unroll
            for (int m = 0; m < 4; ++m) {
                const int row = u.pm * 256 + ai * 128 + wr * 64 + m * 16 + fr;
                const f32x4 a0 = acc[ai][0][m][0] + bv0, a1 = acc[ai][0][m][1] + bv1, g0 = acc[ai][1][m][0] + bg0, g1 = acc[ai][1][m][1] + bg1;
                float r[8];
#pragma unroll
                for (int i = 0; i < 4; ++i) { r[i] = a0[i] / (1.f + __expf(-g0[i])); r[4 + i] = a1[i] / (1.f + __expf(-g1[i])); }
                v4u w; w.x = pk2(r[0], r[1]); w.y = pk2(r[2], r[3]); w.z = pk2(r[4], r[5]); w.w = pk2(r[6], r[7]);
                *(v4u*)(cat + (size_t)row * D + 1024 + j0) = w;
                asm volatile("" ::: "memory");
            }
    }
};
struct EpiRes {
    const float* xin_ctx; const float* xin_lat; float* xo; const float* gate;
    static constexpr bool PERM = false, AFTER_DRAIN = false;
    __device__ __forceinline__ void operator()(const f32x4 (&acc)[2][2][4][2], const Unit& u, int wr, int wc, int fr, int fq) const {
        const int row0 = u.pm * 256;
        const float* gp = gate + (size_t)cond_of_row(row0) * (6 * D);
        const float* xi = row0 < NCTX ? xin_ctx + (size_t)row0 * D : xin_lat + (size_t)(row0 - NCTX) * D;
        float* xout = xo + (size_t)row0 * D;
#pragma unroll
        for (int bj = 0; bj < 2; ++bj) {
            const int col = u.pn * 256 + bj * 128 + wc * 32 + 8 * fq;
            const f32x4 g0 = *(const f32x4*)(gp + col), g1 = *(const f32x4*)(gp + col + 4);
#pragma unroll
            for (int ai = 0; ai < 2; ++ai)
#pragma unroll
                for (int m = 0; m < 4; ++m) {
                    const size_t off = (size_t)(ai * 128 + wr * 64 + m * 16 + fr) * D + col;
                    const f32x4 x0 = *(const f32x4*)(xi + off), x1 = *(const f32x4*)(xi + off + 4);
                    *(f32x4*)(xout + off) = x0 + g0 * acc[ai][bj][m][0];
                    *(f32x4*)(xout + off + 4) = x1 + g1 * acc[ai][bj][m][1];
                    if (m & 1) asm volatile("" ::: "memory");
                }
        }
    }
};
struct EpiSwi {
    bf16* hid;
    static constexpr bool PERM = false, AFTER_DRAIN = false;
    __device__ __forceinline__ void operator()(const f32x4 (&acc)[2][2][4][2], const Unit& u, int wr, int wc, int fr, int fq) const {
        const int j0 = u.pn * 128 + wc * 32 + 8 * fq;
#pragma unroll
        for (int ai = 0; ai < 2; ++ai)
#pragma unroll
            for (int m = 0; m < 4; ++m) {
                const int row = u.pm * 256 + ai * 128 + wr * 64 + m * 16 + fr;
                const f32x4 g0 = acc[ai][0][m][0], g1 = acc[ai][0][m][1], u0 = acc[ai][1][m][0], u1 = acc[ai][1][m][1];
                float r[8];
#pragma unroll
                for (int i = 0; i < 4; ++i) { r[i] = g0[i] / (1.f + __expf(-g0[i])) * u0[i]; r[4 + i] = g1[i] / (1.f + __expf(-g1[i])) * u1[i]; }
                v4u w; w.x = pk2(r[0], r[1]); w.y = pk2(r[2], r[3]); w.z = pk2(r[4], r[5]); w.w = pk2(r[6], r[7]);
                *(v4u*)(hid + (size_t)row * FFH + j0) = w;
                asm volatile("" ::: "memory");
            }
    }
};

#define MFMA16(a, b, c) __builtin_amdgcn_mfma_f32_16x16x32_bf16((a), (b), (c), 0, 0, 0)
constexpr int AK_PITCH = 144, AV_OFF = 256 * AK_PITCH, AV_PITCH = 528, ACHUNK_BYTES = AV_OFF + 64 * AV_PITCH;
template <bool LOCAL, class KF, class VF, class BIAS>
__device__ __forceinline__ void attn_chunk(const bf16x8 (&qf)[2], const KF& kf, const VF& vf, const BIAS& biasf, float& m_run, float& l_run, f32x4 (&o)[4]) {
    f32x4 s[8][2];
#pragma unroll
    for (int p = 0; p < 8; ++p)
#pragma unroll
        for (int blk = 0; blk < 2; ++blk) {
            f32x4 z = {0.f, 0.f, 0.f, 0.f};
            z = MFMA16(kf(p, blk, 0), qf[0], z); z = MFMA16(kf(p, blk, 1), qf[1], z);
            s[p][blk] = z;
        }
    if (LOCAL) {
#pragma unroll
        for (int p = 0; p < 8; ++p)
#pragma unroll
            for (int blk = 0; blk < 2; ++blk)
#pragma unroll
                for (int r = 0; r < 4; ++r) s[p][blk][r] = biasf(p, blk, r, s[p][blk][r]);
    }
    float mx = s[0][0][0];
#pragma unroll
    for (int p = 0; p < 8; ++p)
#pragma unroll
        for (int blk = 0; blk < 2; ++blk)
#pragma unroll
            for (int r = 0; r < 4; ++r) mx = fmaxf(mx, s[p][blk][r]);
    mx = fmaxf(mx, __shfl_xor(mx, 16)); mx = fmaxf(mx, __shfl_xor(mx, 32));
    const float m_new = fmaxf(m_run, mx);
    const float alpha = __builtin_amdgcn_exp2f(m_run - m_new);
    l_run *= alpha;
#pragma unroll
    for (int db = 0; db < 4; ++db) o[db] = o[db] * alpha;
    m_run = m_new;
    float ls = 0.f;
    bf16x8 pb[8];
#pragma unroll
    for (int p = 0; p < 8; ++p) {
        float e[8];
#pragma unroll
        for (int blk = 0; blk < 2; ++blk)
#pragma unroll
            for (int r = 0; r < 4; ++r) { e[blk * 4 + r] = __builtin_amdgcn_exp2f(s[p][blk][r] - m_new); ls += e[blk * 4 + r]; }
        v4u w; w.x = pk2(e[0], e[1]); w.y = pk2(e[2], e[3]); w.z = pk2(e[4], e[5]); w.w = pk2(e[6], e[7]);
        pb[p] = __builtin_bit_cast(bf16x8, w);
    }
    l_run += ls;
#pragma unroll
    for (int p = 0; p < 8; ++p)
#pragma unroll
        for (int db = 0; db < 4; ++db) o[db] = MFMA16(vf(p, db), pb[p], o[db]);
}
__device__ __forceinline__ void attn_store(bf16* cat, int qrow, int h, int g, float l_run, const f32x4 (&o)[4]) {
    float l = l_run; l += __shfl_xor(l, 16); l += __shfl_xor(l, 32);
    const float inv = 1.0f / l;
    bf16* op = cat + (size_t)qrow * D + h * 64 + 4 * g;
#pragma unroll
    for (int db = 0; db < 4; ++db) { v2u w; w.x = pk2(o[db][0] * inv, o[db][1] * inv); w.y = pk2(o[db][2] * inv, o[db][3] * inv); *(v2u*)(op + 16 * db) = w; }
}
struct AStage { v4u k[4], v[4]; };
__device__ __forceinline__ void attn_stage_load(AStage& st, const bf16* kg, const bf16* vg, int vstride, int tid) {
#pragma unroll
    for (int j = 0; j < 4; ++j) { const int idx = tid + 512 * j;
        st.k[j] = *(const v4u*)(kg + (size_t)(idx >> 3) * 64 + (idx & 7) * 8);
        st.v[j] = *(const v4u*)(vg + (size_t)(idx >> 5) * vstride + (idx & 31) * 8); }
}
__device__ __forceinline__ void attn_stage_store(LAS unsigned char* abuf, const AStage& st, int tid) {
#pragma unroll
    for (int j = 0; j < 4; ++j) { const int idx = tid + 512 * j;
        const int key = idx >> 3, c8 = idx & 7, ko = key & 31, row = (key & ~31) + 16 * ((ko >> 2) & 1) + 4 * (ko >> 3) + (ko & 3);
        *(LAS v4u*)(abuf + row * AK_PITCH + c8 * 16) = st.k[j];
        const int d = idx >> 5, c = idx & 31;
        *(LAS v4u*)(abuf + AV_OFF + d * AV_PITCH + c * 16) = st.v[j]; }
}
__device__ __forceinline__ void attn_chunk_lds(const bf16x8 (&qf)[2], const LAS unsigned char* abuf, float& m_run, float& l_run, f32x4 (&o)[4], int lane) {
    const int i = lane & 15, g = lane >> 4;
    const LAS unsigned char* kb = abuf + i * AK_PITCH + 16 * g;
    const LAS unsigned char* vb = abuf + AV_OFF + i * AV_PITCH + 16 * g;
    auto kf = [&](int p, int blk, int ds) { return *(const LAS bf16x8*)(kb + (32 * p + 16 * blk) * AK_PITCH + 64 * ds); };
    auto vf = [&](int p, int db) { return *(const LAS bf16x8*)(vb + (16 * db) * AV_PITCH + 64 * p); };
    auto nb = [&](int, int, int, float v) { return v; };
    attn_chunk<false>(qf, kf, vf, nb, m_run, l_run, o);
}
__device__ __forceinline__ void attn_ctx_task(const bf16* qh, const bf16* kh, const bf16* vt, bf16* cat, LAS unsigned char* abuf, int b, int h, int half, int tid) {
    const int lane = tid & 63, wave = tid >> 6, i = lane & 15, g = lane >> 4, qb = half * 8 + wave;
    const size_t hb = ((size_t)(b * 16 + h)) << 8;
    AStage st; attn_stage_load(st, kh + hb * 64, vt + (((size_t)(b * 16 + h) * 64) << 8), 256, tid);
    const bf16* qp = qh + (hb + qb * 16 + i) * 64 + 8 * g;
    bf16x8 qf[2]; qf[0] = *(const bf16x8*)qp; qf[1] = *(const bf16x8*)(qp + 32);
    attn_stage_store(abuf, st, tid);
    __syncthreads();
    float m_run = -INFINITY, l_run = 0.f; f32x4 o[4];
#pragma unroll
    for (int db = 0; db < 4; ++db) o[db] = (f32x4){0.f, 0.f, 0.f, 0.f};
    attn_chunk_lds(qf, abuf, m_run, l_run, o, lane);
    attn_store(cat, b * 256 + qb * 16 + i, h, g, l_run, o);
}
__device__ __forceinline__ void attn_lat_task(const bf16* qh, const bf16* kh, const bf16* vt, const bf16* kc, const bf16* cvt, const float* rpb_lh, bf16* cat, LAS unsigned char* abuf,
                                              int layer, int b, int h, int rp, int tid) {
    const int lane = tid & 63, wave = tid >> 6, i = lane & 15, g = lane >> 4;
    const int r = 2 * rp + (wave >> 2), cq = wave & 3;
    const int c0 = 16 * cq;
    const int cs0 = (cq == 0) ? 0 : (cq == 1) ? 8 : (cq == 2) ? 24 : 32;
    const int rs = min(max(r - 4, 0), 24);
    const size_t hb = (size_t)NCTX * 16 + (((size_t)(b * 16 + h)) << 11);
    const int tq = r * 64 + c0 + i;
    const size_t cb = ((size_t)(b * 2 + layer) * 16 + h);
    const bf16* ckg = kc + cb * 512 * 64; const bf16* cvg = cvt + cb * 64 * 512;
    AStage st; attn_stage_load(st, ckg, cvg, 512, tid);
    const bf16* qp = qh + (hb + tq) * 64 + 8 * g;
    bf16x8 qf[2]; qf[0] = *(const bf16x8*)qp; qf[1] = *(const bf16x8*)(qp + 32);
    float m_run = -INFINITY, l_run = 0.f; f32x4 o[4];
#pragma unroll
    for (int db = 0; db < 4; ++db) o[db] = (f32x4){0.f, 0.f, 0.f, 0.f};
    attn_stage_store(abuf, st, tid);
    __syncthreads();
    attn_stage_load(st, ckg + 256 * 64, cvg + 256, 512, tid);
    attn_chunk_lds(qf, abuf, m_run, l_run, o, lane);
    __syncthreads();
    attn_stage_store(abuf, st, tid);
    __syncthreads();
    attn_chunk_lds(qf, abuf, m_run, l_run, o, lane);
    {
        const bf16* kbase = kh + (hb + (size_t)rs * 64 + cs0 + 8 * (i >> 2) + (i & 3)) * 64 + 8 * g;
        const bf16* vbase = vt + (size_t)NCTX * 1024 + (((size_t)(b * 16 + h) * 64 + i) << 11) + (size_t)rs * 64 + cs0 + 8 * g;
        auto kf = [&](int p, int blk, int ds) { return *(const bf16x8*)(kbase + (64 * p + 4 * blk) * 64 + 32 * ds); };
        auto vf = [&](int p, int db) { return *(const bf16x8*)(vbase + (size_t)(16 * db) * 2048 + 64 * p); };
        const int c = c0 + i;
        const int cst = min(max(c - 8, 0), 48);
        auto bf = [&](int p, int blk, int rr, float v) {
            const int kcol = cs0 + 8 * g + 4 * blk + rr;
            const int dr = rs + p - r + 7;
            const int dc = min(max(kcol - c, -15), 15) + 15;
            const float bias = rpb_lh[dr * 31 + dc] * LOG2E;
            return (kcol >= cst && kcol < cst + 16) ? v + bias : -1e30f;
        };
        attn_chunk<true>(qf, kf, vf, bf, m_run, l_run, o);
    }
    attn_store(cat, NCTX + b * 2048 + tq, h, g, l_run, o);
}

constexpr int SSM_BU_PITCH = 132;
constexpr int SSM_WAVE_LDS = 16 * SSM_BU_PITCH * 4 + 16 * 272 + 512;
struct SsmPar { float are, aim; bf16x8 bb[8]; bf16x8 cf[4]; };
__device__ __forceinline__ void ssm_params(SsmPar& P, const Args& a, int layer, int dir, int g, LAS float* coefl, int lane) {
    const int ldg = (layer * 2 + dir) * 32 + g;
    const float lre = a.in[I_ARE][(size_t)ldg * 64 + lane], lim = a.in[I_AIM][(size_t)ldg * 64 + lane];
    const float dt = expf(a.in[I_LDT][ldg]);
    const float mag = expf(lre * dt);
    float ang = lim * dt;
    const float kq = rintf(ang * 0.15915494309189535f);
    ang = fmaf(-kq, 6.2831854820251465f, ang); ang = fmaf(-kq, -1.7484555e-07f, ang);
    const float sn = sinf(ang), cs = cosf(ang);
    P.are = mag * cs; P.aim = mag * sn;
    const float xr = P.are - 1.0f, xi = P.aim, den = 1.0f / (lre * lre + lim * lim);
    coefl[2 * lane] = (xr * lre + xi * lim) * den; coefl[2 * lane + 1] = (xi * lre - xr * lim) * den;
    LDS_WAIT(); asm volatile("" ::: "memory");
    const int nrow = lane & 15, gq = lane >> 4, m0 = 8 * (gq & 1);
#pragma unroll
    for (int blk = 0; blk < 8; ++blk) {
        const int n = 16 * blk + nrow, p = n >> 1, comp = n & 1;
        const float cr = coefl[2 * p], ci = coefl[2 * p + 1];
        const float* br = a.in[I_BRE] + ((size_t)ldg * 64 + p) * 16 + m0; const float* bi = a.in[I_BIM] + ((size_t)ldg * 64 + p) * 16 + m0;
        const f32x4 r0 = *(const f32x4*)br, r1 = *(const f32x4*)(br + 4), i0 = *(const f32x4*)bi, i1 = *(const f32x4*)(bi + 4);
        float v[8];
#pragma unroll
        for (int e = 0; e < 4; ++e) { v[e] = comp ? cr * i0[e] + ci * r0[e] : cr * r0[e] - ci * i0[e]; v[4 + e] = comp ? cr * i1[e] + ci * r1[e] : cr * r1[e] - ci * i1[e]; }
        v4u w; w.x = pk2(v[0], v[1]); w.y = pk2(v[2], v[3]); w.z = pk2(v[4], v[5]); w.w = pk2(v[6], v[7]);
        P.bb[blk] = __builtin_bit_cast(bf16x8, w);
    }
    const float* cre = a.in[I_CRE] + ((size_t)ldg * 16 + nrow) * 64; const float* cim = a.in[I_CIM] + ((size_t)ldg * 16 + nrow) * 64;
#pragma unroll
    for (int s = 0; s < 4; ++s) {
        const int p0 = 16 * s + 4 * gq;
        const f32x4 r4 = *(const f32x4*)(cre + p0), i4 = *(const f32x4*)(cim + p0);
        v4u w; w.x = pk2(r4[0], -i4[0]); w.y = pk2(r4[1], -i4[1]); w.z = pk2(r4[2], -i4[2]); w.w = pk2(r4[3], -i4[3]);
        P.cf[s] = __builtin_bit_cast(bf16x8, w);
    }
}
template <bool DO_Y>
__device__ __forceinline__ void ssm_scan256(const SsmPar& P, const float* ub, float* ybuf, int row0, int dir, int g, float& hr, float& hi, LAS float* bul, LAS unsigned* hb, int lane) {
    const int col = lane & 15, gq = lane >> 4;
    const float* up = ub + (size_t)(row0 + (dir ? 240 : 0) + col) * 512 + g * 16 + 8 * (gq & 1);
    const long ustep = dir ? -16 * 512 : 16 * 512;
    f32x4 n0 = *(const f32x4*)up, n1 = *(const f32x4*)(up + 4);
#pragma unroll 1
    for (int sb = 0; sb < 16; ++sb) {
        const int tb = dir ? 240 - 16 * sb : 16 * sb;
        const f32x4 c0 = n0, c1 = n1;
        if (sb < 15) { up += ustep; n0 = *(const f32x4*)up; n1 = *(const f32x4*)(up + 4); }
        unsigned w0 = pk2(c0[0], c0[1]), w1 = pk2(c0[2], c0[3]), w2 = pk2(c1[0], c1[1]), w3 = pk2(c1[2], c1[3]);
        if (gq >= 2) {
            w0 = pk2(c0[0] - __uint_as_float(w0 << 16), c0[1] - __uint_as_float(w0 & 0xffff0000u));
            w1 = pk2(c0[2] - __uint_as_float(w1 << 16), c0[3] - __uint_as_float(w1 & 0xffff0000u));
            w2 = pk2(c1[0] - __uint_as_float(w2 << 16), c1[1] - __uint_as_float(w2 & 0xffff0000u));
            w3 = pk2(c1[2] - __uint_as_float(w3 << 16), c1[3] - __uint_as_float(w3 & 0xffff0000u));
        }
        const bf16x8 uf = __builtin_bit_cast(bf16x8, (v4u){w0, w1, w2, w3});
#pragma unroll
        for (int blk = 0; blk < 8; ++blk) {
            f32x4 d = {0.f, 0.f, 0.f, 0.f};
            d = MFMA16(P.bb[blk], uf, d);
            *(LAS f32x4*)(bul + col * SSM_BU_PITCH + 16 * blk + 4 * gq) = d;
        }
        LDS_WAIT(); asm volatile("" ::: "memory");
        f32x2 bu[16];
#pragma unroll
        for (int i = 0; i < 16; ++i) { const int ti = dir ? 15 - i : i; bu[i] = *(const LAS f32x2*)(bul + ti * SSM_BU_PITCH + 2 * lane); }
#pragma unroll
        for (int i = 0; i < 16; ++i) {
            const int ti = dir ? 15 - i : i;
            const float nr = fmaf(P.are, hr, fmaf(-P.aim, hi, bu[i][0]));
            const float ni = fmaf(P.are, hi, fmaf(P.aim, hr, bu[i][1]));
            hr = nr; hi = ni;
            if (DO_Y) hb[ti * 68 + lane] = pk2(hr, hi);
        }
        if (DO_Y) {
            LDS_WAIT(); asm volatile("" ::: "memory");
            f32x4 y = {0.f, 0.f, 0.f, 0.f};
#pragma unroll
            for (int s = 0; s < 4; ++s) {
                const bf16x8 bfr = *(const LAS bf16x8*)((const LAS unsigned char*)hb + col * 272 + (32 * s + 8 * gq) * 2);
                y = MFMA16(P.cf[s], bfr, y);
            }
            *(f32x4*)(ybuf + (size_t)(row0 + tb + col) * 512 + g * 16 + 4 * gq) = y;
        }
        LDS_WAIT(); asm volatile("" ::: "memory");
    }
}
template <int W>
__device__ __forceinline__ void pool_task(const float* PB, bf16* CAT, int row0, int seq0, int n, int ch) {
    float v[47];
    const int t0 = row0 - seq0;
#pragma unroll
    for (int i = 0; i < 47; ++i) { const int t = t0 - 8 + i; v[i] = (t >= 0 && t < n) ? PB[(size_t)(seq0 + t) * 512 + ch] : 0.f; }
#pragma unroll
    for (int i = 0; i < 32; ++i) {
        const int t = t0 + i;
        const int lo = max(t - W / 2, 0), hi2 = min(t - W / 2 + W, n);
        float s = 0.f;
#pragma unroll
        for (int j = 0; j < W; ++j) s += v[i + 8 - W / 2 + j];
        const float o = s / (float)(hi2 - lo) - v[i + 8];
        CAT[(size_t)(row0 + i) * D + 1536 + ch] = (bf16)f2bf(o);
    }
}

constexpr int NPH = 3 + 9 * DEPTH;
__global__ void __launch_bounds__(512, 2) mega_fwd(Args args) {
    extern __shared__ __attribute__((aligned(16))) unsigned char lds_raw[];
    LAS unsigned char* lds = (LAS unsigned char*)lds_raw;
    volatile LAS unsigned* MISC = (volatile LAS unsigned*)(lds + MISC_OFF);
    const int tid0 = threadIdx.x;
    const int G = gridDim.x;
    for (int u = tid0; u < (LDS_BYTES - LDSCTL_OFF) / 4; u += 512) ((LAS unsigned*)(lds + LDSCTL_OFF))[u] = 0u;
    __syncthreads();
    XcdBarrier bar; bar.bar = (unsigned*)(args.ws + WS_CTL) + CW_BAR; bar.x = 0; bar.st = nullptr;
    const bool multi = (args.ph_hi - args.ph_lo) > 1;
    if (multi) bar = xcd_barrier_post((unsigned*)(args.ws + WS_CTL) + CW_BAR, MISC + 8);

#pragma unroll 1
    for (int ph = args.ph_lo; ph < args.ph_hi; ++ph) {
        const int layer = ph < 3 ? 0 : (ph - 3) / 9;
        const int kind = ph < 3 ? ph : 3 + (ph - 3) % 9;
#define PHASE_IDS int tid = threadIdx.x; asm volatile("" : "+v"(tid)); const int lane = tid & 63, wave = __builtin_amdgcn_readfirstlane(tid >> 6); \
        int bx = blockIdx.x; asm volatile("" : "+s"(bx)); const int vcu = (G % 8 == 0) ? (bx % 8) * (G / 8) + bx / 8 : bx; const int gw = vcu * 8 + wave, NGW = G * 8; (void)lane; (void)gw; (void)NGW;
        const int nrep = (((REPMASK) >> kind) & 1) && (REPLAYER < 0 || REPLAYER == layer) ? 2 : 1;
#pragma unroll 1
        for (int rep = 0; rep < nrep; ++rep) {
        size_t opq = 0; asm volatile("" : "+s"(opq));
        unsigned char* ws = args.ws + opq;
        float* modp = (float*)(ws + WS_MODP); float* modf = (float*)(ws + WS_MODF);
        bf16* kcb = (bf16*)(ws + WS_KC); bf16* cvt = (bf16*)(ws + WS_CVT);
        bf16* Hb = (bf16*)(ws + WS_H); bf16* QH = (bf16*)(ws + WS_QH); bf16* KH = (bf16*)(ws + WS_KH); bf16* VT = (bf16*)(ws + WS_VT);
        float* UB = (float*)(ws + WS_UB); float* PB = (float*)(ws + WS_PB); float* YF = (float*)(ws + WS_YF); float* YB = (float*)(ws + WS_YB);
        bf16* YA = (bf16*)(ws + WS_YA); bf16* CAT = (bf16*)(ws + WS_CAT); float* XA = (float*)(ws + WS_XA); bf16* HID = (bf16*)(ws + WS_HID);
        bf16* WIN = (bf16*)(ws + WS_WIN) + (size_t)layer * INW * D;
        bf16* WOUT = (bf16*)(ws + WS_WOUT) + (size_t)layer * D * D;
        bf16* WFI = (bf16*)(ws + WS_WFI) + (size_t)layer * 2 * FFH * D;
        bf16* WFO = (bf16*)(ws + WS_WFO) + (size_t)layer * D * FFH;
        bf16* WGLU = (bf16*)(ws + WS_WGLU) + (size_t)layer * 1024 * 512;
        const float* modl = modf + (size_t)layer * 3 * (6 * D);

        if (PHON(0) && kind == 0) { PHASE_IDS
            LAS float* scr = (LAS float*)(lds + wave * 16640);
            constexpr int N_MODP = 2 * 16 * 48;
            constexpr int T_IN = 32 * 56, T_OUT = 32 * 32, T_FI = 32 * 176, T_FO = 88 * 32, T_GLU = 8 * 16, T_L = T_IN + T_OUT + T_FI + T_FO + T_GLU;
            constexpr int N_FOLD = 2 * 4 * 256, N_CACHE = 4096;
            constexpr int NITEMS = N_MODP + 2 * T_L + N_FOLD + 2 * N_CACHE;
            for (int it = gw; it < NITEMS; it += NGW) {
                int r = it;
                if (r < N_MODP) { const int l = r / 768, q = r % 768; modp_item(args.in[I_WMOD], args.in[I_C], args.in[I_CCTX], modp, l, q / 48, q % 48, lane); continue; } r -= N_MODP;
                if (r < 2 * T_L) {
                    const int l = r / T_L; r %= T_L;
                    if (r < T_IN) { transpose_item(args.in[I_WIN] + (size_t)l * D * INW, INW, D, (bf16*)(ws + WS_WIN) + (size_t)l * INW * D, 0, 0, scr, r / 56, r % 56, lane); continue; } r -= T_IN;
                    if (r < T_OUT) { transpose_item(args.in[I_WOUT] + (size_t)l * D * D, D, D, (bf16*)(ws + WS_WOUT) + (size_t)l * D * D, 0, 0, scr, r / 32, r % 32, lane); continue; } r -= T_OUT;
                    if (r < T_FI) { transpose_item(args.in[I_WFI] + (size_t)l * D * 2 * FFH, 2 * FFH, D, (bf16*)(ws + WS_WFI) + (size_t)l * 2 * FFH * D, 1, FFH, scr, r / 176, r % 176, lane); continue; } r -= T_FI;
                    if (r < T_FO) { transpose_item(args.in[I_WFO] + (size_t)l * FFH * D, D, FFH, (bf16*)(ws + WS_WFO) + (size_t)l * D * FFH, 0, 0, scr, r / 32, r % 32, lane); continue; } r -= T_FO;
                    transpose_item(args.in[I_WGLU] + (size_t)l * 512 * 1024, 1024, 512, (bf16*)(ws + WS_WGLU) + (size_t)l * 1024 * 512, 1, 512, scr, r / 16, r % 16, lane); continue;
                }
                r -= 2 * T_L;
                if (r < N_FOLD) { const int l = r / 1024, q = r % 1024; fold_item(args.in[I_WIN] + (size_t)l * D * INW, args.in[I_POOLW] + (size_t)l * 4 * 128 * 128, args.in[I_POOLS] + (size_t)l * 512,
                                                                              (bf16*)(ws + WS_WIN) + (size_t)l * INW * D, q / 256, q % 256, lane); continue; }
                r -= N_FOLD;
                if (r < N_CACHE) {
                    const size_t e = (size_t)r * 512 + lane * 8;
                    const f32x4 a0 = *(const f32x4*)(args.in[I_CK] + e), a1 = *(const f32x4*)(args.in[I_CK] + e + 4);
                    v4u w; w.x = pk2(a0[0], a0[1]); w.y = pk2(a0[2], a0[3]); w.z = pk2(a1[0], a1[1]); w.w = pk2(a1[2], a1[3]);
                    *(v4u*)(kcb + e) = w; continue;
                }
                r -= N_CACHE;
                {
                    const int blh = r >> 6, rem = r & 63, dgrp = rem >> 3, tg = rem & 7;
                    const int t0 = tg * 64 + lane;
                    const float* src = args.in[I_CV] + ((size_t)blh * 512 + t0) * 64 + dgrp * 8;
                    const f32x4 a0 = *(const f32x4*)src, a1 = *(const f32x4*)(src + 4);
                    bf16* dst = cvt + ((size_t)blh * 64 + dgrp * 8) * 512 + t0;
                    dst[0] = (bf16)f2bf(a0[0]); dst[512] = (bf16)f2bf(a0[1]); dst[1024] = (bf16)f2bf(a0[2]); dst[1536] = (bf16)f2bf(a0[3]);
                    dst[2048] = (bf16)f2bf(a1[0]); dst[2560] = (bf16)f2bf(a1[1]); dst[3072] = (bf16)f2bf(a1[2]); dst[3584] = (bf16)f2bf(a1[3]);
                }
            }
        } else if (PHON(1) && kind == 1) { PHASE_IDS
            for (int e = bx * 512 + tid; e < 2 * 3 * 6 * D; e += G * 512) {
                const int l = e / (3 * 6 * D), rj = e % (3 * 6 * D), rr = rj / (6 * D), j = rj % (6 * D);
                float s = args.in[I_BMOD][(size_t)l * 6 * D + j];
#pragma unroll
                for (int kc = 0; kc < 16; ++kc) s += modp[((size_t)(l * 16 + kc) * 3 + rr) * (6 * D) + j];
                modf[e] = s;
            }
        } else if (PHON(2) && (kind == 2 || kind == 8 || kind == 11)) { PHASE_IDS
            const bool fin = (kind == 11 && layer == DEPTH - 1);
            const int nl = (kind == 11) ? layer + 1 : layer;
            const int which = (kind == 8) ? 3 : 0;
            for (int row = gw; row < MTOK; row += NGW) {
                const float* xr = (kind == 2) ? (row < NCTX ? args.in[I_XP] + (size_t)row * D : args.in[I_XS] + (size_t)(row - NCTX) * D) : XA + (size_t)row * D;
                if (fin) { norm_row(xr, args.in[I_FNG], nullptr, nullptr, nullptr, args.out + (size_t)row * D, lane); }
                else {
                    const float* mrow = modf + ((size_t)nl * 3 + cond_of_row(row)) * (6 * D);
                    const float* gain = (kind == 8 ? args.in[I_N2G] : args.in[I_N1G]) + (size_t)nl * D;
                    norm_row(xr, gain, mrow + which * D, mrow + (which + 1) * D, Hb + (size_t)row * D, nullptr, lane);
                }
            }
        } else if (PHON(3) && kind == 3) { PHASE_IDS
            pg8::Gemm g{Hb, WIN, MTOK, INW, D}; pg8::StaticOrder S; S.init(MTOK, INW, G, bx);
            EpiIn E{QH, KH, VT, UB, PB, args.out + OUT_CK, args.out + OUT_CV, layer};
            pg8::gemm_phase<EpiIn, pg8::StaticOrder, true, true>(lds, g, S, E, tid);
        } else if (PHON(4) && kind == 4) { PHASE_IDS
            constexpr int T_AL = 512, T_SL = 128, T_AC = 1024, T_SC = 256, T_PL = 384, T_ALL = T_AL + T_SL + T_AC + T_SC + T_PL;
            LAS unsigned char* abuf = lds;
            LAS float* bul = (LAS float*)(lds + wave * SSM_WAVE_LDS);
            LAS unsigned* hbuf = (LAS unsigned*)(lds + wave * SSM_WAVE_LDS + 16 * SSM_BU_PITCH * 4);
            LAS float* coefl = (LAS float*)(lds + wave * SSM_WAVE_LDS + 16 * SSM_BU_PITCH * 4 + 16 * 272);
            LAS float* Fl = (LAS float*)(lds + 8 * SSM_WAVE_LDS);
            volatile LAS int* slot = (volatile LAS int*)(lds + 8 * SSM_WAVE_LDS + 4096);
            unsigned* qctr = (unsigned*)(ws + WS_CTL) + CW_TASK + 64 * (layer * 2 + rep);
            if (tid == 0) slot[0] = (int)__hip_atomic_fetch_add(qctr, 1u, __ATOMIC_RELAXED, __HIP_MEMORY_SCOPE_AGENT);
            __syncthreads();
            int cur = __builtin_amdgcn_readfirstlane(slot[0]); int par = 1;
            while (cur < T_ALL) {
                if (tid == 0) slot[par] = (int)__hip_atomic_fetch_add(qctr, 1u, __ATOMIC_RELAXED, __HIP_MEMORY_SCOPE_AGENT);
                int r = cur;
                int tl = lane; asm volatile("" : "+v"(tl));
                const int tidl = wave * 64 + tl;
                const int mm = rep ? MIXMASK : 31;
                if (r < T_AL) {
                    if (mm & 2) { const int b = r >> 8, h = (r >> 4) & 15, rp = r & 15;
                        attn_lat_task(QH, KH, VT, kcb, cvt, args.in[I_RPB] + ((size_t)layer * 16 + h) * 15 * 31, CAT, abuf, layer, b, h, rp, tidl); }
                } else if ((r -= T_AL) < T_SL) {
                    if (mm & 1) {
                    const int b = r >> 6, g = (r >> 1) & 31, dir = r & 1, c = wave;
                    SsmPar P; ssm_params(P, args, layer, dir, g, coefl, tl);
                    const int row0 = NCTX + b * 2048 + 256 * c;
                    float hr = 0.f, hi = 0.f;
                    ssm_scan256<false>(P, UB, nullptr, row0, dir, g, hr, hi, bul, hbuf, tl);
                    Fl[(c * 64 + tl) * 2] = hr; Fl[(c * 64 + tl) * 2 + 1] = hi;
                    __syncthreads();
                    float pr = P.are, pi = P.aim;
#pragma unroll
                    for (int q = 0; q < 8; ++q) { const float nr = pr * pr - pi * pi, ni = 2.f * pr * pi; pr = nr; pi = ni; }
                    const float* st = args.in[I_ST] + ((((size_t)(b * 2 + layer) * 2 + dir) * 32 + g) * 64 + tl) * 2;
                    hr = st[0]; hi = st[1];
                    if (dir == 0) { for (int cc = 0; cc < c; ++cc) { const float fr_ = Fl[(cc * 64 + tl) * 2], fi_ = Fl[(cc * 64 + tl) * 2 + 1]; const float nr = pr * hr - pi * hi + fr_, ni = pr * hi + pi * hr + fi_; hr = nr; hi = ni; } }
                    else { for (int cc = 7; cc > c; --cc) { const float fr_ = Fl[(cc * 64 + tl) * 2], fi_ = Fl[(cc * 64 + tl) * 2 + 1]; const float nr = pr * hr - pi * hi + fr_, ni = pr * hi + pi * hr + fi_; hr = nr; hi = ni; } }
                    ssm_scan256<true>(P, UB, dir ? YB : YF, row0, dir, g, hr, hi, bul, hbuf, tl);
                    }
                } else if ((r -= T_SL) < T_AC) {
                    if (mm & 8) { const int b = r >> 5, h = (r >> 1) & 15, half = r & 1; attn_ctx_task(QH, KH, VT, CAT, abuf, b, h, half, tidl); }
                } else if ((r -= T_AC) < T_SC) {
                    if (mm & 4) {
                    const int item = r * 8 + wave; const int b = item >> 6, g = (item >> 1) & 31, dir = item & 1;
                    SsmPar P; ssm_params(P, args, layer, dir, g, coefl, tl);
                    float hr = 0.f, hi = 0.f;
                    ssm_scan256<true>(P, UB, dir ? YB : YF, b * 256, dir, g, hr, hi, bul, hbuf, tl);
                    float* so = args.out + OUT_ST + ((((size_t)(b * 2 + layer) * 2 + dir) * 32 + g) * 64 + tl) * 2;
                    *(f32x2*)so = (f32x2){hr, hi};
                    }
                } else {
                    r -= T_SC;
                    if (mm & 16) {
                    const int row0 = r * 32; const int ch = tidl;
                    const int seq0 = row0 < NCTX ? (row0 & ~255) : NCTX + ((row0 - NCTX) & ~2047);
                    const int n = row0 < NCTX ? 256 : 2048;
                    const int grp = __builtin_amdgcn_readfirstlane(ch >> 7);
                    if (grp == 0) pool_task<2>(PB, CAT, row0, seq0, n, ch);
                    else if (grp == 1) pool_task<4>(PB, CAT, row0, seq0, n, ch);
                    else if (grp == 2) pool_task<8>(PB, CAT, row0, seq0, n, ch);
                    else pool_task<16>(PB, CAT, row0, seq0, n, ch);
                    }
                }
                __syncthreads();
                cur = __builtin_amdgcn_readfirstlane(slot[par]); par ^= 1;
            }
        } else if (PHON(5) && kind == 5) { PHASE_IDS
            const float* dsk = args.in[I_SD] + (size_t)layer * 512;
            for (size_t e4 = (size_t)bx * 512 + tid; e4 < (size_t)MTOK * 128; e4 += (size_t)G * 512) {
                const int c4 = (int)(e4 & 127) * 4;
                const f32x4 u = *(const f32x4*)(UB + e4 * 4), yf = *(const f32x4*)(YF + e4 * 4), yb = *(const f32x4*)(YB + e4 * 4), dd = *(const f32x4*)(dsk + c4);
                float o[4];
#pragma unroll
                for (int i = 0; i < 4; ++i) { const float x = dd[i] * u[i] + yf[i] + yb[i]; const float z = 0.7978845608028654f * (x + 0.044715f * x * x * x); o[i] = x / (1.f + __expf(-2.f * z)); }
                v2u w; w.x = pk2(o[0], o[1]); w.y = pk2(o[2], o[3]);
                *(v2u*)(YA + e4 * 4) = w;
            }
        } else if (PHON(6) && kind == 6) { PHASE_IDS
            pg8::Gemm g{YA, WGLU, MTOK, 1024, 512}; pg8::StaticOrder S; S.init(MTOK, 1024, G, bx);
            EpiGlu E{CAT, args.in[I_BGLU] + (size_t)layer * 1024};
            pg8::gemm_phase<EpiGlu, pg8::StaticOrder, true, true>(lds, g, S, E, tid);
        } else if (PHON(7) && kind == 7) { PHASE_IDS
            pg8::Gemm g{CAT, WOUT, MTOK, D, D}; pg8::StaticOrder S; S.init(MTOK, D, G, bx);
            EpiRes E{layer == 0 ? args.in[I_XP] : XA, layer == 0 ? args.in[I_XS] : XA + (size_t)NCTX * D, XA, modl + 2 * D};
            pg8::gemm_phase<EpiRes, pg8::StaticOrder, true, true>(lds, g, S, E, tid);
        } else if (PHON(9) && kind == 9) { PHASE_IDS
            pg8::Gemm g{Hb, WFI, MTOK, 2 * FFH, D}; pg8::StaticOrder S; S.init(MTOK, 2 * FFH, G, bx);
            EpiSwi E{HID};
            pg8::gemm_phase<EpiSwi, pg8::StaticOrder, true, true>(lds, g, S, E, tid);
        } else if (PHON(10) && kind == 10) { PHASE_IDS
            pg8::Gemm g{HID, WFO, MTOK, D, FFH}; pg8::StaticOrder S; S.init(MTOK, D, G, bx);
            EpiRes E{XA, XA + (size_t)NCTX * D, XA, modl + 5 * D};
            pg8::gemm_phase<EpiRes, pg8::StaticOrder, true, true>(lds, g, S, E, tid);
        }
        if (ph + 1 < args.ph_hi || rep + 1 < nrep) xcd_barrier(bar);
        }
    }
}

extern "C" void kernel_launch(void* const* d_in, const int* in_sizes, int n_in, void* d_out, int out_size, void* d_ws, size_t ws_size, hipStream_t stream) {
    static int grid = 0;
    if (grid == 0) {
        if (n_in != 29 || ws_size < WS_END) { fprintf(stderr, "kernel_launch: need 29 inputs and >= %zu bytes of workspace; got %d, %zu\n", (size_t)WS_END, n_in, ws_size); grid = -1; return; }
        int dev = 0, cus = 0;
        if (hipGetDevice(&dev) != hipSuccess || hipDeviceGetAttribute(&cus, hipDeviceAttributeMultiprocessorCount, dev) != hipSuccess) { grid = -1; return; }
        if (hipFuncSetAttribute((const void*)mega_fwd, hipFuncAttributeMaxDynamicSharedMemorySize, LDS_BYTES) != hipSuccess) { fprintf(stderr, "kernel_launch: hipFuncSetAttribute failed\n"); grid = -1; return; }
        (void)hipGetLastError();
        grid = cus;
    }
    if (grid < 0) return;
    (void)hipMemsetAsync((char*)d_ws + WS_CTL, 0, CTL_ZERO_BYTES, stream);
    Args a{};
    for (int i = 0; i < 29; ++i) a.in[i] = (const float*)d_in[i];
    a.out = (float*)d_out; a.ws = (unsigned char*)d_ws;
#if MK_N_LAUNCHES == 1
    a.ph_lo = 0; a.ph_hi = NPH;
    hipLaunchKernelGGL(mega_fwd, dim3(grid), dim3(512), LDS_BYTES, stream, a);
#else
    for (int p = 0; p < NPH; ++p) { a.ph_lo = p; a.ph_hi = p + 1; hipLaunchKernelGGL(mega_fwd, dim3(grid), dim3(512), LDS_BYTES, stream, a); }
#endif
}
```
